# Optimizing an MI355X kernel written in HIP

```python
import math
import jax
import jax.numpy as jnp
from jax import lax
import numpy as np

D_MODEL = 1024
BATCH = 2
SEQ = 8192
DEPTH = 2

GRID_W = 64
CTX_LEN = 256

NA_HEADS = 8
HEAD_DIM = 64
NA_W = NA_HEADS * HEAD_DIM
NA_WIN_R = 8
NA_WIN_C = 16
ROPE_THETA = 10000.0
HY_W = 256
HY_ORDER = 2
HY_SHORT = 3
HY_BANDS = 16
HY_EMB = 1 + 2 * HY_BANDS
HY_FO = 64
HY_DECAY_TARGET = 1e-2
HY_FAST_DECAY = 0.3
HY_SLOW_DECAY = 1.5
POOL_W = 256
POOL_SIZES = (2, 4, 8, 16)
POOL_GROUP = POOL_W // len(POOL_SIZES)

MIX_W = NA_W + HY_W + POOL_W
IN_W = 3 * NA_W + (HY_ORDER + 1) * HY_W + POOL_W

N_EXPERTS = 16
EC_FACTOR = 2
D_EXPERT = 2048

EPS = 1e-6

kernel_name = 'hybrid_natten_hyena_pool_ecmoe_dit'


def rmsnorm(x, w):
    xf = x.astype(jnp.float32)
    y = xf * lax.rsqrt(jnp.mean(xf * xf, axis=-1, keepdims=True) + EPS)
    return (y * w.astype(jnp.float32)).astype(x.dtype)


def modulate(h, shift, scale):
    return h * (1.0 + scale) + shift


def split_heads(u):
    return u.reshape(u.shape[:-1] + (NA_HEADS, HEAD_DIM))


def axial_rope(n_tokens):
    t = jnp.arange(n_tokens, dtype=jnp.int32)
    pos = jnp.stack([t // GRID_W, t % GRID_W], axis=-1).astype(jnp.float32)
    nf = HEAD_DIM // 4
    inv = ROPE_THETA ** (-jnp.arange(nf, dtype=jnp.float32) / nf)
    ang = pos[:, :, None] * inv
    return jnp.cos(ang), jnp.sin(ang)


def apply_rope(x, cos, sin):
    B, N, H, dh = x.shape
    xr = x.reshape(B, N, H, 2, 2, dh // 4)
    a, b = xr[..., 0, :], xr[..., 1, :]
    c = cos[None, :, None].astype(x.dtype)
    s = sin[None, :, None].astype(x.dtype)
    return jnp.stack([a * c - b * s, b * c + a * s], axis=-2).reshape(B, N, H, dh)


def dense_attention(q, k, v):
    s = jnp.einsum('bqhd,bkhd->bhqk', q, k).astype(jnp.float32) * (q.shape[-1] ** -0.5)
    p = jax.nn.softmax(s, axis=-1).astype(v.dtype)
    return jnp.einsum('bhqk,bkhd->bqhd', p, v)


def neighborhood_attention(q, k, v, q_plain, kc, vc, rpb):
    B, N, H, dh = q.shape
    rows = N // GRID_W
    wr = min(NA_WIN_R, rows)
    scale = dh ** -0.5
    grid = lambda a: a.reshape(B, rows, GRID_W, H, dh)
    qg, qpg, kg, vg = grid(q), grid(q_plain), grid(k), grid(v)
    col = jnp.arange(GRID_W)
    col_start = jnp.clip(col - NA_WIN_C // 2, 0, GRID_W - NA_WIN_C)
    col_idx = col_start[:, None] + jnp.arange(NA_WIN_C)[None, :]
    col_bias_idx = col_idx - col[:, None] + (NA_WIN_C - 1)
    rpb_f = rpb.astype(jnp.float32)

    def row_block(r):
        rs = jnp.clip(r - NA_WIN_R // 2, 0, rows - wr)
        q_r = lax.dynamic_index_in_dim(qg, r, axis=1, keepdims=False)
        qp_r = lax.dynamic_index_in_dim(qpg, r, axis=1, keepdims=False)
        k_win = lax.dynamic_slice_in_dim(kg, rs, wr, axis=1)[:, :, col_idx]
        v_win = lax.dynamic_slice_in_dim(vg, rs, wr, axis=1)[:, :, col_idx]
        s_lat = jnp.einsum('bqhd,biqjhd->bhqij', q_r, k_win).astype(jnp.float32) * scale
        row_bias_idx = rs + jnp.arange(wr) - r + (NA_WIN_R - 1)
        bias = rpb_f[:, row_bias_idx[:, None, None], col_bias_idx[None]].transpose(0, 2, 1, 3)
        s_lat = (s_lat + bias).reshape(B, H, GRID_W, wr * NA_WIN_C)
        s_ctx = jnp.einsum('bqhd,bkhd->bhqk', qp_r, kc).astype(jnp.float32) * scale
        p = jax.nn.softmax(jnp.concatenate([s_lat, s_ctx], axis=-1), axis=-1).astype(v.dtype)
        p_lat = p[..., :wr * NA_WIN_C].reshape(B, H, GRID_W, wr, NA_WIN_C)
        p_ctx = p[..., wr * NA_WIN_C:]
        return (jnp.einsum('bhqij,biqjhd->bqhd', p_lat, v_win)
                + jnp.einsum('bhqk,bkhd->bqhd', p_ctx, vc))

    out = lax.map(row_block, jnp.arange(rows))
    return out.transpose(1, 0, 2, 3, 4).reshape(B, N, H * dh)


def short_conv(u, w, b):
    L = u.shape[1]
    pad = HY_SHORT // 2
    up = jnp.pad(u, ((0, 0), (pad, pad), (0, 0)))
    y = b
    for j in range(HY_SHORT):
        y = y + up[:, j:j + L] * w[j]
    return y


def hyena_filter(L, w1, b1, w2, b2, w3, freq):
    f32 = jnp.float32
    t = jnp.linspace(0.0, 1.0, L, dtype=f32)[:, None]
    w = (2.0 * math.pi / L) * jnp.arange(L, dtype=f32)[:, None]
    f = jnp.linspace(1e-4, HY_BANDS - 1, HY_BANDS, dtype=f32)[None, :]
    z = jnp.concatenate([t, jnp.cos(f * w), -jnp.sin(f * w)], axis=-1)
    fr = freq.astype(f32)
    h = jnp.sin(fr * (z @ w1.astype(f32) + b1.astype(f32)))
    h = jnp.sin(fr * (h @ w2.astype(f32) + b2.astype(f32)))
    h = (h @ w3.astype(f32)).reshape(L, HY_ORDER, 2, HY_W)
    deltas = jnp.abs(jnp.linspace(math.log(HY_DECAY_TARGET) / HY_SLOW_DECAY,
                                  math.log(HY_DECAY_TARGET) / HY_FAST_DECAY, HY_W, dtype=f32))
    h = h * jnp.exp(-t * deltas)[:, None, None, :]
    hf, hb = h[:, :, 0], h[:, :, 1]
    k2 = jnp.concatenate([hf, jnp.zeros_like(hf[:1]), hb[:0:-1]], axis=0)
    k2 = k2 * lax.rsqrt(jnp.sum(k2 * k2, axis=0, keepdims=True) + EPS)
    return jnp.fft.rfft(k2, axis=0)


def fft_conv(u, kf):
    L = u.shape[1]
    U = jnp.fft.rfft(u.astype(jnp.float32), n=2 * L, axis=1)
    return jnp.fft.irfft(U * kf[None], n=2 * L, axis=1)[:, :L].astype(u.dtype)


def hyena_mixer(u, kf, conv_w, conv_b, skip):
    u = short_conv(u, conv_w, conv_b)
    x1, x2, v = jnp.split(u, 3, axis=-1)
    z = v
    for o, gate in enumerate((x1, x2)):
        z = gate * (fft_conv(z, kf[:, o]) + z * skip[o])
    return z


def pool_mixer(u, pool_w, pool_scale):
    B, L, _ = u.shape
    uf = u.astype(jnp.float32)
    csum = jnp.pad(jnp.cumsum(uf, axis=1), ((0, 0), (1, 0), (0, 0)))
    t = jnp.arange(L)
    outs = []
    for g, w in enumerate(POOL_SIZES):
        lo = jnp.clip(t - w // 2, 0, L)
        hi = jnp.clip(t - w // 2 + w, 0, L)
        sl = slice(g * POOL_GROUP, (g + 1) * POOL_GROUP)
        mean = (csum[:, hi, sl] - csum[:, lo, sl]) / (hi - lo).astype(jnp.float32)[:, None]
        outs.append(jnp.einsum('blc,cd->bld', (mean - uf[..., sl]).astype(u.dtype), pool_w[g]))
    return jnp.concatenate(outs, axis=-1) * pool_scale


def expert_choice_moe(h, w_router, w_gate, w_up, w_down):
    B, N, _ = h.shape
    cap = EC_FACTOR * N // N_EXPERTS
    aff = jax.nn.softmax(jnp.einsum('bnd,de->bne', h, w_router).astype(jnp.float32), axis=-1)
    gate, idx = lax.top_k(aff.transpose(0, 2, 1), cap)
    bidx = jnp.arange(B)[:, None, None]
    xg = h[bidx, idx]
    a = jnp.einsum('becd,edf->becf', xg, w_gate)
    b = jnp.einsum('becd,edf->becf', xg, w_up)
    y = jnp.einsum('becf,efd->becd', jax.nn.silu(a) * b, w_down)
    y = (y * gate[..., None].astype(y.dtype)).astype(h.dtype)
    return jnp.zeros_like(h).at[bidx, idx].add(y)


def trunk_layer(xl, xc, c, c_ctx, rope_cos, rope_sin, p, last):
    B, N, _ = xl.shape
    mod_l = (jax.nn.silu(c) @ p['w_mod'] + p['b_mod'])[:, None, :]
    mod_c = jax.nn.silu(c_ctx) @ p['w_mod'] + p['b_mod']
    sh1, sc1, g1, sh2, sc2, g2 = jnp.split(mod_l, 6, axis=-1)
    csh1, csc1, cg1, csh2, csc2, cg2 = jnp.split(mod_c, 6, axis=-1)
    w_in = p['w_in']
    hy_cols = slice(3 * NA_W, 3 * NA_W + 3 * HY_W)
    pool_cols = slice(3 * NA_W + 3 * HY_W, IN_W)

    hc = modulate(rmsnorm(xc, p['norm1_w']), csh1, csc1)
    if last:
        uc = hc @ w_in[:, NA_W:3 * NA_W]
        kc = rmsnorm(split_heads(uc[..., :NA_W]), p['k_norm_w'])
        vc = split_heads(uc[..., NA_W:])
        xc_new = None
    else:
        uc = hc @ w_in
        qc = rmsnorm(split_heads(uc[..., :NA_W]), p['q_norm_w'])
        kc = rmsnorm(split_heads(uc[..., NA_W:2 * NA_W]), p['k_norm_w'])
        vc = split_heads(uc[..., 2 * NA_W:3 * NA_W])
        ctx_kf = hyena_filter(xc.shape[1], p['hy_w1'], p['hy_b1'], p['hy_w2'], p['hy_b2'], p['hy_w3'], p['hy_freq'])
        mix_c = jnp.concatenate([
            dense_attention(qc, kc, vc).reshape(B, xc.shape[1], NA_W),
            hyena_mixer(uc[..., hy_cols], ctx_kf, p['hy_conv_w'], p['hy_conv_b'], p['hy_skip']),
            pool_mixer(uc[..., pool_cols], p['pool_w'], p['pool_scale'])], axis=-1)
        xc_new = xc + cg1 * (mix_c @ p['w_out'])
        h2c = modulate(rmsnorm(xc_new, p['norm2_w']), csh2, csc2)
        xc_new = xc_new + cg2 * expert_choice_moe(h2c, p['w_router'], p['w_gate'], p['w_up'], p['w_down'])

    hl = modulate(rmsnorm(xl, p['norm1_w']), sh1, sc1)
    ul = hl @ w_in
    ql = rmsnorm(split_heads(ul[..., :NA_W]), p['q_norm_w'])
    kl = apply_rope(rmsnorm(split_heads(ul[..., NA_W:2 * NA_W]), p['k_norm_w']), rope_cos, rope_sin)
    vl = split_heads(ul[..., 2 * NA_W:3 * NA_W])
    o_na = neighborhood_attention(apply_rope(ql, rope_cos, rope_sin), kl, vl, ql, kc, vc, p['na_rpb'])
    lat_kf = hyena_filter(N, p['hy_w1'], p['hy_b1'], p['hy_w2'], p['hy_b2'], p['hy_w3'], p['hy_freq'])
    mix_l = jnp.concatenate([
        o_na,
        hyena_mixer(ul[..., hy_cols], lat_kf, p['hy_conv_w'], p['hy_conv_b'], p['hy_skip']),
        pool_mixer(ul[..., pool_cols], p['pool_w'], p['pool_scale'])], axis=-1)
    xl_new = xl + g1 * (mix_l @ p['w_out'])
    h2l = modulate(rmsnorm(xl_new, p['norm2_w']), sh2, sc2)
    xl_new = xl_new + g2 * expert_choice_moe(h2l, p['w_router'], p['w_gate'], p['w_up'], p['w_down'])
    return xl_new, xc_new


def setup_inputs(seed: int = 0) -> dict:
    key = jax.random.key(seed)
    ks = iter(jax.random.split(key, 40))
    D = D_MODEL

    def nrm(shape, scale):
        return jax.random.normal(next(ks), shape, jnp.float32) * scale

    return {
        'x': nrm((BATCH, SEQ, D), 1.0),
        'c': nrm((BATCH, D), 1.0),
        'ctx': nrm((BATCH, CTX_LEN, D), 1.0),
        'c_ctx': nrm((D,), 1.0),
        'w_mod': nrm((DEPTH, D, 6 * D), 0.5 * D ** -0.5),
        'b_mod': nrm((DEPTH, 6 * D), 0.02),
        'norm1_w': 1.0 + nrm((DEPTH, D), 0.02),
        'norm2_w': 1.0 + nrm((DEPTH, D), 0.02),
        'w_in': nrm((DEPTH, D, IN_W), D ** -0.5),
        'w_out': nrm((DEPTH, MIX_W, D), MIX_W ** -0.5),
        'q_norm_w': 1.0 + nrm((DEPTH, HEAD_DIM), 0.02),
        'k_norm_w': 1.0 + nrm((DEPTH, HEAD_DIM), 0.02),
        'na_rpb': nrm((DEPTH, NA_HEADS, 2 * NA_WIN_R - 1, 2 * NA_WIN_C - 1), 0.1),
        'hy_conv_w': nrm((DEPTH, HY_SHORT, 3 * HY_W), HY_SHORT ** -0.5),
        'hy_conv_b': nrm((DEPTH, 3 * HY_W), 0.02),
        'hy_w1': nrm((DEPTH, HY_EMB, HY_FO), HY_EMB ** -0.5),
        'hy_b1': nrm((DEPTH, HY_FO), 0.02),
        'hy_w2': nrm((DEPTH, HY_FO, HY_FO), HY_FO ** -0.5),
        'hy_b2': nrm((DEPTH, HY_FO), 0.02),
        'hy_w3': nrm((DEPTH, HY_FO, HY_ORDER * 2 * HY_W), HY_FO ** -0.5),
        'hy_freq': 1.0 + nrm((DEPTH, HY_FO), 0.1),
        'hy_skip': nrm((DEPTH, HY_ORDER, HY_W), 0.5),
        'pool_w': nrm((DEPTH, len(POOL_SIZES), POOL_GROUP, POOL_GROUP), POOL_GROUP ** -0.5),
        'pool_scale': 1.0 + nrm((DEPTH, POOL_W), 0.02),
        'w_router': nrm((DEPTH, D, N_EXPERTS), D ** -0.5),
        'w_gate': nrm((DEPTH, N_EXPERTS, D, D_EXPERT), D ** -0.5),
        'w_up': nrm((DEPTH, N_EXPERTS, D, D_EXPERT), D ** -0.5),
        'w_down': nrm((DEPTH, N_EXPERTS, D_EXPERT, D), D_EXPERT ** -0.5),
    }


def reference(x, c, ctx, c_ctx, w_mod, b_mod, norm1_w, norm2_w, w_in, w_out, q_norm_w, k_norm_w, na_rpb,
              hy_conv_w, hy_conv_b, hy_w1, hy_b1, hy_w2, hy_b2, hy_w3, hy_freq, hy_skip,
              pool_w, pool_scale, w_router, w_gate, w_up, w_down):
    rope_cos, rope_sin = axial_rope(x.shape[1])
    xl, xc = x, ctx
    for i in range(DEPTH):
        p = {
            'w_mod': w_mod[i], 'b_mod': b_mod[i], 'norm1_w': norm1_w[i], 'norm2_w': norm2_w[i],
            'w_in': w_in[i], 'w_out': w_out[i], 'q_norm_w': q_norm_w[i], 'k_norm_w': k_norm_w[i],
            'na_rpb': na_rpb[i], 'hy_conv_w': hy_conv_w[i], 'hy_conv_b': hy_conv_b[i],
            'hy_w1': hy_w1[i], 'hy_b1': hy_b1[i], 'hy_w2': hy_w2[i], 'hy_b2': hy_b2[i], 'hy_w3': hy_w3[i],
            'hy_freq': hy_freq[i], 'hy_skip': hy_skip[i], 'pool_w': pool_w[i], 'pool_scale': pool_scale[i],
            'w_router': w_router[i], 'w_gate': w_gate[i], 'w_up': w_up[i], 'w_down': w_down[i],
        }
        xl, xc = trunk_layer(xl, xc, c, c_ctx, rope_cos, rope_sin, p, i == DEPTH - 1)
    return xl
```

```cpp
#include <hip/hip_runtime.h>
#include <hip/hip_cooperative_groups.h>
#include <cstdio>
#include <cstdint>
namespace cg = cooperative_groups;

typedef unsigned short u16;
typedef __attribute__((ext_vector_type(8))) short bf16x8;
typedef __attribute__((ext_vector_type(4))) float f32x4;
typedef __attribute__((ext_vector_type(16))) float f32x16;

#define MLAT 16384
#define MTOT 16896
#define EPSF 1e-6f

struct Params {
  const float *x, *c, *ctx, *c_ctx, *w_mod, *b_mod, *norm1_w, *norm2_w, *w_in, *w_out, *q_norm_w, *k_norm_w, *na_rpb,
      *hy_conv_w, *hy_conv_b, *hy_w1, *hy_b1, *hy_w2, *hy_b2, *hy_w3, *hy_freq, *hy_skip, *pool_w, *pool_scale,
      *w_router, *w_gate, *w_up, *w_down;
  float* out;
  char* ws;
};

constexpr size_t OFF_WINT = 0;
constexpr size_t OFF_WOUTT = OFF_WINT + 2ull * 2560 * 1024 * 2;
constexpr size_t OFF_WGUT = OFF_WOUTT + 2ull * 1024 * 1024 * 2;
constexpr size_t OFF_WDT = OFF_WGUT + 2ull * 16 * 4096 * 1024 * 2;
constexpr size_t OFF_MODS = OFF_WDT + 2ull * 16 * 1024 * 2048 * 2;
constexpr size_t OFF_ROPE = OFF_MODS + 2ull * 3 * 6144 * 4;
constexpr size_t OFF_HYH = OFF_ROPE + 2ull * 2048 * 4;
constexpr size_t OFF_FILT = OFF_HYH + 2ull * 8448 * 64 * 4;
constexpr size_t OFF_FILTC = OFF_FILT + 2ull * 2 * 256 * 16384 * 2;
constexpr size_t OFF_FSS = OFF_FILTC + 2ull * 256 * 512 * 2;
constexpr size_t OFF_CNT = OFF_FSS + 2048ull * 4;
constexpr size_t OFF_CLAIM = OFF_CNT + 256;
constexpr size_t OFF_BAR = OFF_CLAIM + 4ull * 2048 * 4;
constexpr size_t OFF_HL = OFF_BAR + 16384;
constexpr size_t OFF_H2 = OFF_HL + (size_t)MTOT * 1024 * 2;
constexpr size_t OFF_UL = OFF_H2 + (size_t)MTOT * 1024 * 2;
constexpr size_t OFF_QROT = OFF_UL + (size_t)MTOT * 2560 * 2;
constexpr size_t OFF_VT = OFF_QROT + (size_t)MLAT * 512 * 2;
constexpr size_t OFF_UT = OFF_VT + 512ull * MTOT * 2;
constexpr size_t OFF_MIX = OFF_UT + 768ull * MTOT * 2;
constexpr size_t OFF_XNEW = OFF_MIX + (size_t)MTOT * 1024 * 2;
constexpr size_t OFF_AFF = OFF_XNEW + (size_t)MTOT * 1024 * 4;
constexpr size_t OFF_AFFC = OFF_AFF + 2ull * 16 * 8192 * 4;
constexpr size_t OFF_SELI = OFF_AFFC + 2ull * 16 * 256 * 4;
constexpr size_t OFF_SELIC = OFF_SELI + 32ull * 1024 * 4;
constexpr size_t OFF_SELG = OFF_SELIC + 32ull * 32 * 4;
constexpr size_t OFF_SELGC = OFF_SELG + 32ull * 1024 * 4;
constexpr size_t OFF_ACT = OFF_SELGC + 32ull * 32 * 4;
constexpr size_t OFF_ACTC = OFF_ACT + 32ull * 1024 * 2048 * 2;
constexpr size_t WS_TOTAL = OFF_ACTC + 32ull * 32 * 2048 * 2;

#ifndef REP_MASK
#define REP_MASK 0
#endif
#define NREP(bit) ((REP_MASK >> (bit)) & 1 ? 2 : 1)
#define GSYNC() do { xcd_barrier(xb); if (REP_MASK & 256) xcd_barrier(xb); } while (0)
#define LAUNDER(v) asm volatile("" : "+s"(v))
__device__ __forceinline__ unsigned xcc_id() { return (unsigned)__builtin_amdgcn_s_getreg(20 | (3 << 11)) & 0xfu; }
__device__ __forceinline__ unsigned cu_key() { return ((unsigned)__builtin_amdgcn_s_getreg(63492) >> 8) & 0xffu; }

#define XB_TMO      128
#define XB_XCNT(j)  (256  + 64 * (j))
#define XB_XSUB(j)  (1280 + 64 * (j))
#define XB_XGEN(j)  (2304 + 64 * (j))
#define XB_TOP      3328
#define XB_TOPGEN   3392
#define XCD_BAR_WORDS 3456
#define XB_SPIN_CAP (1u << 20)
#define LAS __attribute__((address_space(3)))
__device__ __forceinline__ unsigned xb_ld(unsigned* p) { return __hip_atomic_load(p, __ATOMIC_RELAXED, __HIP_MEMORY_SCOPE_AGENT); }
__device__ __forceinline__ unsigned xb_add(unsigned* p, unsigned v) { return __hip_atomic_fetch_add(p, v, __ATOMIC_RELAXED, __HIP_MEMORY_SCOPE_AGENT); }
#define XB_SPIN(cond, bar) do { unsigned _sp = 0; while (cond) { __builtin_amdgcn_s_sleep(1); \
    if ((++_sp & 255u) == 0u) { if (xb_ld(&(bar)[XB_TMO])) break; if (_sp > XB_SPIN_CAP) { atomicAdd(&(bar)[XB_TMO], 1u); break; } } } } while (0)
struct XcdBarrier { unsigned* bar; unsigned x; volatile LAS unsigned* st; };
__device__ __forceinline__ XcdBarrier xcd_barrier_post(unsigned* bar, volatile LAS unsigned* st) {
  XcdBarrier b; b.bar = bar; b.x = xcc_id(); b.st = st;
  if (threadIdx.x == 0) (void)xb_add(&bar[XB_XCNT(b.x)], 1u);
  return b;
}
__device__ __forceinline__ void xcd_barrier_complete(unsigned* bar, unsigned x, unsigned& nloc, unsigned& nx) {
  const unsigned G = gridDim.x * gridDim.y * gridDim.z;
  unsigned sum, cnt, mine, sp = 0u;
  for (;;) {
    sum = 0u; cnt = 0u; mine = 0u;
#pragma unroll
    for (unsigned j = 0; j < 16; ++j) { const unsigned c = xb_ld(&bar[XB_XCNT(j)]); sum += c; cnt += (c > 0u) ? 1u : 0u; mine = (j == x) ? c : mine; }
    if (sum == G) break;
    __builtin_amdgcn_s_sleep(1);
    if ((++sp & 255u) == 0u) { if (xb_ld(&bar[XB_TMO])) break; if (sp > XB_SPIN_CAP) { atomicAdd(&bar[XB_TMO], 1u); break; } }
  }
  nloc = mine > 0u ? mine : 1u; nx = cnt > 0u ? cnt : 1u;
}
__device__ __forceinline__ void xcd_barrier(const XcdBarrier& b) {
  asm volatile("s_waitcnt vmcnt(0)" ::: "memory");
  __syncthreads();
  if (threadIdx.x == 0) {
    unsigned* bar = b.bar;
    __builtin_amdgcn_s_waitcnt(0);
    unsigned nloc = b.st[0], nx = b.st[1];
    if (nloc == 0u) { xcd_barrier_complete(bar, b.x, nloc, nx); b.st[0] = nloc; b.st[1] = nx; }
    const unsigned old = xb_add(&bar[XB_XSUB(b.x)], 1u);
    const unsigned gen = old / nloc;
    if (old + 1u == (gen + 1u) * nloc) {
      __builtin_amdgcn_fence(__ATOMIC_RELEASE, "agent");
      asm volatile("s_waitcnt vmcnt(0)" ::: "memory");
      const unsigned og = xb_add(&bar[XB_TOP], 1u);
      const unsigned tg = og / nx;
      if (og + 1u == (tg + 1u) * nx) xb_add(&bar[XB_TOPGEN], 1u);
      else XB_SPIN(xb_ld(&bar[XB_TOPGEN]) == tg, bar);
      __builtin_amdgcn_fence(__ATOMIC_ACQUIRE, "agent");
      xb_add(&bar[XB_XGEN(b.x)], 1u);
      asm volatile("s_waitcnt vmcnt(0)" ::: "memory");
    } else {
      XB_SPIN(xb_ld(&bar[XB_XGEN(b.x)]) == gen, bar);
      __builtin_amdgcn_fence(__ATOMIC_ACQUIRE, "agent");
      asm volatile("s_waitcnt vmcnt(0)" ::: "memory");
    }
  }
  __syncthreads();
}

__device__ __forceinline__ int vtid() { int t = threadIdx.x; asm volatile("" : "+v"(t)); return t; }
__device__ __forceinline__ u16 f2bf(float f) {
  unsigned u = __float_as_uint(f);
  u += 0x7fffu + ((u >> 16) & 1u);
  return (u16)(u >> 16);
}
__device__ __forceinline__ float bf2f(u16 h) { return __uint_as_float(((unsigned)h) << 16); }
__device__ __forceinline__ unsigned pack2(float a, float b) { return (unsigned)f2bf(a) | ((unsigned)f2bf(b) << 16); }
__device__ __forceinline__ float wave_sum(float v) {
#pragma unroll
  for (int o = 32; o > 0; o >>= 1) v += __shfl_xor(v, o);
  return v;
}
__device__ __forceinline__ float siluf(float x) { return x / (1.f + __expf(-x)); }
__device__ __forceinline__ int gu_row(int mat, int f) {
  int jt = f >> 6, rem = f & 63, wc = rem >> 5, n = (rem >> 4) & 1, i = rem & 15;
  return jt * 128 + wc * 64 + (n + 2 * mat) * 16 + i;
}

template <int K, class FA, class FB, class Epi>
__device__ __forceinline__ void gemm_tile(char* smem, int nvalid_rows, FA rowA, FB rowB, Epi epi) {
  const int tid = vtid(), lane = tid & 63, wid = tid >> 6, wr = wid >> 1, wc = wid & 1, fr = lane & 15, fq = lane >> 4;
  const int seg = tid & 3, r0 = tid >> 2;
  int msub = (nvalid_rows - wr * 128 + 15) >> 4;
  msub = msub < 0 ? 0 : (msub > 8 ? 8 : msub);
  const u16* pa0 = rowA(r0) + seg * 8;
  const u16* pa1 = rowA(r0 + 64) + seg * 8;
  const u16* pa2 = rowA(r0 + 128) + seg * 8;
  const u16* pa3 = rowA(r0 + 192) + seg * 8;
  const u16* pb0 = rowB(r0) + seg * 8;
  const u16* pb1 = rowB(r0 + 64) + seg * 8;
  f32x4 acc[8][4];
#pragma unroll
  for (int m = 0; m < 8; ++m)
#pragma unroll
    for (int n = 0; n < 4; ++n) acc[m][n] = (f32x4){0.f, 0.f, 0.f, 0.f};
  uint4 ra0, ra1, ra2, ra3, rb0, rb1;
  ra0 = *(const uint4*)pa0; ra1 = *(const uint4*)pa1; ra2 = *(const uint4*)pa2; ra3 = *(const uint4*)pa3;
  rb0 = *(const uint4*)pb0; rb1 = *(const uint4*)pb1;
  constexpr int NK = K / 32;
  const int wsw = (seg ^ ((r0 >> 2) & 3)) * 8;
  const int wofsA = r0 * 32 + wsw, wofsB = 256 * 32 + r0 * 32 + wsw;
  __syncthreads();
  {
    u16* B0 = (u16*)smem;
    *(uint4*)&B0[wofsA] = ra0; *(uint4*)&B0[wofsA + 64 * 32] = ra1;
    *(uint4*)&B0[wofsA + 128 * 32] = ra2; *(uint4*)&B0[wofsA + 192 * 32] = ra3;
    *(uint4*)&B0[wofsB] = rb0; *(uint4*)&B0[wofsB + 64 * 32] = rb1;
  }
  ra0 = *(const uint4*)(pa0 + 32); ra1 = *(const uint4*)(pa1 + 32); ra2 = *(const uint4*)(pa2 + 32); ra3 = *(const uint4*)(pa3 + 32);
  rb0 = *(const uint4*)(pb0 + 32); rb1 = *(const uint4*)(pb1 + 32);
  __syncthreads();
  const int rsw = (fq ^ ((fr >> 2) & 3)) * 8;
  const int rdA = (wr * 128 + fr) * 32 + rsw, rdB = 256 * 32 + (wc * 64 + fr) * 32 + rsw;
  for (int kt = 0; kt < NK; ++kt) {
    const u16* Bc = (const u16*)(smem + (kt & 1) * 24576);
    bf16x8 Bt[4];
#pragma unroll
    for (int n = 0; n < 4; ++n) Bt[n] = *(const bf16x8*)&Bc[rdB + n * 16 * 32];
    if (msub > 0) {
      bf16x8 At[4];
#pragma unroll
      for (int m = 0; m < 4; ++m) At[m] = *(const bf16x8*)&Bc[rdA + m * 16 * 32];
      __builtin_amdgcn_s_setprio(1);
#pragma unroll
      for (int m = 0; m < 4; ++m)
#pragma unroll
        for (int n = 0; n < 4; ++n) acc[m][n] = __builtin_amdgcn_mfma_f32_16x16x32_bf16(At[m], Bt[n], acc[m][n], 0, 0, 0);
      __builtin_amdgcn_s_setprio(0);
    }
    if (msub > 4) {
      bf16x8 At[4];
#pragma unroll
      for (int m = 0; m < 4; ++m) At[m] = *(const bf16x8*)&Bc[rdA + (m + 4) * 16 * 32];
      __builtin_amdgcn_s_setprio(1);
#pragma unroll
      for (int m = 0; m < 4; ++m)
#pragma unroll
        for (int n = 0; n < 4; ++n) acc[m + 4][n] = __builtin_amdgcn_mfma_f32_16x16x32_bf16(At[m], Bt[n], acc[m + 4][n], 0, 0, 0);
      __builtin_amdgcn_s_setprio(0);
    }
    if (kt + 1 < NK) {
      u16* Bn = (u16*)(smem + ((kt + 1) & 1) * 24576);
      *(uint4*)&Bn[wofsA] = ra0; *(uint4*)&Bn[wofsA + 64 * 32] = ra1;
      *(uint4*)&Bn[wofsA + 128 * 32] = ra2; *(uint4*)&Bn[wofsA + 192 * 32] = ra3;
      *(uint4*)&Bn[wofsB] = rb0; *(uint4*)&Bn[wofsB + 64 * 32] = rb1;
    }
    if (kt + 2 < NK) {
      const int ko = (kt + 2) * 32;
      ra0 = *(const uint4*)(pa0 + ko); ra1 = *(const uint4*)(pa1 + ko); ra2 = *(const uint4*)(pa2 + ko); ra3 = *(const uint4*)(pa3 + ko);
      rb0 = *(const uint4*)(pb0 + ko); rb1 = *(const uint4*)(pb1 + ko);
    }
    __syncthreads();
  }
  epi(acc, wr, wc, fr, fq);
}

struct TrJob { const float* src; u16* dst; int K, N, kt, nt, mode; };
constexpr int TJ_PER_LAYER = 640 + 256 + 16 * 1536;
constexpr int NJ_TR = 2 * TJ_PER_LAYER;
constexpr int TR_DEFER = 10240, TR_CHUNK = 16, J_DEFER = NJ_TR - TR_DEFER;
constexpr int NJ_MOD = 192;
constexpr int NJ_HID = 2 * 256 + 8;
constexpr int NJ_P0 = NJ_TR + NJ_MOD + NJ_HID + 1;

__device__ __forceinline__ TrJob tr_decode(const Params& p, char* ws, int job) {
  TrJob t;
  int l = job / TJ_PER_LAYER, rj = job % TJ_PER_LAYER;
  if (rj < 640) {
    t.src = p.w_in + (size_t)l * 1024 * 2560; t.K = 1024; t.N = 2560; t.kt = rj / 40; t.nt = rj % 40;
    t.dst = (u16*)(ws + OFF_WINT) + (size_t)l * 2560 * 1024; t.mode = 0;
  } else if (rj < 896) {
    rj -= 640;
    t.src = p.w_out + (size_t)l * 1024 * 1024; t.K = 1024; t.N = 1024; t.kt = rj / 16; t.nt = rj % 16;
    t.dst = (u16*)(ws + OFF_WOUTT) + (size_t)l * 1024 * 1024; t.mode = 0;
  } else {
    rj -= 896;
    int e = rj / 1536, q = rj % 1536;
    size_t eo = (size_t)(l * 16 + e);
    if (q < 512) {
      t.src = p.w_gate + eo * 1024 * 2048; t.K = 1024; t.N = 2048; t.kt = q / 32; t.nt = q % 32;
      t.dst = (u16*)(ws + OFF_WGUT) + eo * 4096 * 1024; t.mode = 1;
    } else if (q < 1024) {
      q -= 512;
      t.src = p.w_up + eo * 1024 * 2048; t.K = 1024; t.N = 2048; t.kt = q / 32; t.nt = q % 32;
      t.dst = (u16*)(ws + OFF_WGUT) + eo * 4096 * 1024; t.mode = 2;
    } else {
      q -= 1024;
      t.src = p.w_down + eo * 2048 * 1024; t.K = 2048; t.N = 1024; t.kt = q / 16; t.nt = q % 16;
      t.dst = (u16*)(ws + OFF_WDT) + eo * 1024 * 2048; t.mode = 0;
    }
  }
  return t;
}
__device__ __forceinline__ void tr_load(const Params& p, char* ws, int job, int tid, float4 (&r)[4]) {
  TrJob t = tr_decode(p, ws, job);
  const int c4 = tid & 15, rr = tid >> 4;
  const float* s0 = t.src + (size_t)(t.kt * 64 + rr) * t.N + t.nt * 64 + c4 * 4;
#pragma unroll
  for (int pp = 0; pp < 4; ++pp) {
    f32x4 v_ = __builtin_nontemporal_load((const f32x4*)(s0 + (size_t)(16 * pp) * t.N));
    r[pp] = make_float4(v_[0], v_[1], v_[2], v_[3]);
  }
}
__device__ __forceinline__ void tr_lds_write(float* tile, int tid, const float4 (&r)[4]) {
  const int c4 = tid & 15, rr = tid >> 4;
#pragma unroll
  for (int pp = 0; pp < 4; ++pp) {
    float* t = &tile[(rr + 16 * pp) * 65 + c4 * 4];
    t[0] = r[pp].x; t[1] = r[pp].y; t[2] = r[pp].z; t[3] = r[pp].w;
  }
}
__device__ __forceinline__ void tr_store(const Params& p, char* ws, int job, int tid, const float* tile) {
  TrJob t = tr_decode(p, ws, job);
  const int kc = tid & 7, nn = tid >> 3;
#pragma unroll
  for (int pp = 0; pp < 2; ++pp) {
    int n = nn + 32 * pp;
    float v[8];
#pragma unroll
    for (int j = 0; j < 8; ++j) v[j] = tile[(kc * 8 + j) * 65 + n];
    uint4 o;
    o.x = pack2(v[0], v[1]); o.y = pack2(v[2], v[3]); o.z = pack2(v[4], v[5]); o.w = pack2(v[6], v[7]);
    int gn = t.nt * 64 + n;
    int drow = t.mode == 0 ? gn : gu_row(t.mode - 1, gn);
    *(uint4*)&t.dst[(size_t)drow * t.K + t.kt * 64 + kc * 8] = o;
  }
}
__device__ __forceinline__ void p0_transposes(const Params& p, char* smem, int bid, int nb, int jlo, int jhi) {
  const int tid = vtid();
  char* ws = p.ws;
  LAUNDER(ws);
  float* tileA = (float*)smem;
  float* tileB = tileA + 64 * 65;
  float4 c0[4], c1[4], n0[4], n1[4];
  int j = jlo + bid * 2;
  if (j < jhi) { tr_load(p, ws, j, tid, c0); tr_load(p, ws, j + 1, tid, c1); }
  for (; j < jhi; j += 2 * nb) {
    const int jn = j + 2 * nb;
    if (jn < jhi) { tr_load(p, ws, jn, tid, n0); tr_load(p, ws, jn + 1, tid, n1); }
    tr_lds_write(tileA, tid, c0);
    tr_lds_write(tileB, tid, c1);
    __syncthreads();
    tr_store(p, ws, j, tid, tileA);
    tr_store(p, ws, j + 1, tid, tileB);
    __syncthreads();
#pragma unroll
    for (int q = 0; q < 4; ++q) { c0[q] = n0[q]; c1[q] = n1[q]; }
  }
}

__device__ __forceinline__ void p0_job(const Params& p, char* smem, int job) {
  const int tid = vtid();
  char* ws = p.ws;
  LAUNDER(ws);
  job -= NJ_TR;
  if (job < NJ_MOD) {
    int l = job / 96, cch = job % 96;
    float* sv = (float*)smem;
    for (int i = tid; i < 3072; i += 256) {
      int v = i >> 10, k = i & 1023;
      float s = v < 2 ? p.c[v * 1024 + k] : p.c_ctx[k];
      sv[i] = siluf(s);
    }
    __syncthreads();
    int cj = tid & 63, ks = tid >> 6, col = cch * 64 + cj;
    const float* W = p.w_mod + (size_t)l * 1024 * 6144;
    float a0 = 0.f, a1 = 0.f, a2 = 0.f;
    for (int k = ks * 256; k < ks * 256 + 256; ++k) {
      float w = W[(size_t)k * 6144 + col];
      a0 += sv[k] * w; a1 += sv[1024 + k] * w; a2 += sv[2048 + k] * w;
    }
    __syncthreads();
    sv[(ks * 3 + 0) * 64 + cj] = a0; sv[(ks * 3 + 1) * 64 + cj] = a1; sv[(ks * 3 + 2) * 64 + cj] = a2;
    __syncthreads();
    if (ks < 3) {
      int v = ks;
      float s = sv[(0 * 3 + v) * 64 + cj] + sv[(1 * 3 + v) * 64 + cj] + sv[(2 * 3 + v) * 64 + cj] + sv[(3 * 3 + v) * 64 + cj];
      ((float*)(ws + OFF_MODS))[(l * 3 + v) * 6144 + col] = s + p.b_mod[l * 6144 + col];
    }
    __syncthreads();
    return;
  }
  job -= NJ_MOD;
  if (job < NJ_HID) {
    int l, Lsel, tch;
    if (job < 512) { l = job >> 8; Lsel = 0; tch = job & 255; } else { l = 0; Lsel = 1; tch = job - 512; }
    const int L = Lsel ? 256 : 8192;
    float* zf = (float*)smem;
    float* h1s = zf + 4 * 36;
    const int tg = tid >> 6, j = tid & 63;
    const float* w1 = p.hy_w1 + l * 33 * 64;
    const float* w2 = p.hy_w2 + l * 64 * 64;
    const float b1 = p.hy_b1[l * 64 + j], b2 = p.hy_b2[l * 64 + j], fr = p.hy_freq[l * 64 + j];
    const float wstep = (float)(2.0 * 3.14159265358979323846 / (double)L);
    for (int step = 0; step < 8; ++step) {
      int t = tch * 32 + step * 4 + tg;
      if (j < 33) {
        float z;
        if (j == 0) z = (float)t / (float)(L - 1);
        else {
          int bnd = (j - 1) & 15;
          float f = 1e-4f + (float)bnd * ((15.0f - 1e-4f) / 15.0f);
          float w = wstep * (float)t;
          z = (j <= 16) ? cosf(f * w) : -sinf(f * w);
        }
        zf[tg * 36 + j] = z;
      }
      __syncthreads();
      float a = b1;
      for (int i = 0; i < 33; ++i) a += zf[tg * 36 + i] * w1[i * 64 + j];
      h1s[tg * 64 + j] = sinf(fr * a);
      __syncthreads();
      float a2 = b2;
      for (int i = 0; i < 64; ++i) a2 += h1s[tg * 64 + i] * w2[i * 64 + j];
      ((float*)(ws + OFF_HYH))[((size_t)l * 8448 + (Lsel ? 8192 : 0) + t) * 64 + j] = sinf(fr * a2);
    }
    __syncthreads();
    return;
  }
  {
    float* rope = (float*)(ws + OFF_ROPE);
    for (int i = tid; i < 2048; i += 256) {
      int pos = i >> 4, f = i & 15;
      float inv = powf(10000.0f, -(float)f / 16.0f);
      float ang = (float)pos * inv;
      rope[i] = cosf(ang);
      rope[2048 + i] = sinf(ang);
    }
    float* fss = (float*)(ws + OFF_FSS);
    for (int i = tid; i < 2048; i += 256) fss[i] = 0.f;
    int* cnt = (int*)(ws + OFF_CNT);
    if (tid < 64) cnt[tid] = 0;
    int* claim = (int*)(ws + OFF_CLAIM);
    for (int i = tid; i < 4 * 2048; i += 256) claim[i] = 0;
  }
}

__device__ __forceinline__ void norm_job(const Params& p, int l, int job, bool from_x) {
  const int tid = vtid(), lane = tid & 63, wid = tid >> 6;
  char* ws = p.ws;
  LAUNDER(ws); LAUNDER(l);
  u16* HL = (u16*)(ws + OFF_HL);
  const float* nw = p.norm1_w + l * 1024;
  const int rowbase0 = job * 64 + wid * 16;
  const float* src0;
  if (from_x) src0 = rowbase0 < MLAT ? p.x + (size_t)rowbase0 * 1024 : p.ctx + (size_t)(rowbase0 - MLAT) * 1024;
  else src0 = (const float*)(ws + OFF_XNEW) + (size_t)rowbase0 * 1024;
  float4 nx0, nx1, nx2, nx3;
  nx0 = *(const float4*)&src0[lane * 4]; nx1 = *(const float4*)&src0[lane * 4 + 256];
  nx2 = *(const float4*)&src0[lane * 4 + 512]; nx3 = *(const float4*)&src0[lane * 4 + 768];
  for (int i = 0; i < 16; ++i) {
    int row = rowbase0 + i;
    int v = row < MLAT ? (row >> 13) : 2;
    const float* mods = (const float*)(ws + OFF_MODS) + (l * 3 + v) * 6144;
    float4 xv[4];
    xv[0] = nx0; xv[1] = nx1; xv[2] = nx2; xv[3] = nx3;
    if (i + 1 < 16) {
      const float* sn = src0 + (size_t)(i + 1) * 1024;
      nx0 = *(const float4*)&sn[lane * 4]; nx1 = *(const float4*)&sn[lane * 4 + 256];
      nx2 = *(const float4*)&sn[lane * 4 + 512]; nx3 = *(const float4*)&sn[lane * 4 + 768];
    }
    float ss = 0.f;
#pragma unroll
    for (int q = 0; q < 4; ++q) {
      ss += xv[q].x * xv[q].x + xv[q].y * xv[q].y + xv[q].z * xv[q].z + xv[q].w * xv[q].w;
    }
    ss = wave_sum(ss);
    float rstd = rsqrtf(ss * (1.f / 1024.f) + EPSF);
    if (from_x) {
      float* dstr = (float*)(ws + OFF_XNEW) + (size_t)row * 1024;
#pragma unroll
      for (int q = 0; q < 4; ++q) *(float4*)&dstr[lane * 4 + 256 * q] = xv[q];
    } else if (row < MLAT) {
      float* dstr = p.out + (size_t)row * 1024;
#pragma unroll
      for (int q = 0; q < 4; ++q) *(float4*)&dstr[lane * 4 + 256 * q] = xv[q];
    }
#pragma unroll
    for (int q = 0; q < 4; ++q) {
      int col = lane * 4 + 256 * q;
      float4 w = *(const float4*)&nw[col];
      float4 sh = *(const float4*)&mods[col];
      float4 sc = *(const float4*)&mods[1024 + col];
      float o0 = xv[q].x * rstd * w.x * (1.f + sc.x) + sh.x;
      float o1 = xv[q].y * rstd * w.y * (1.f + sc.y) + sh.y;
      float o2 = xv[q].z * rstd * w.z * (1.f + sc.z) + sh.z;
      float o3 = xv[q].w * rstd * w.w * (1.f + sc.w) + sh.w;
      uint2 o; o.x = pack2(o0, o1); o.y = pack2(o2, o3);
      *(uint2*)&HL[(size_t)row * 1024 + col] = o;
    }
  }
}

__device__ __forceinline__ void taps_job(const Params& p, char* smem, int l, int Lsel, int tch, int cc) {
  const int tid = vtid();
  char* ws = p.ws;
  LAUNDER(ws); LAUNDER(l);
  const int L = Lsel ? 256 : 8192;
  float* hs = (float*)smem;
  u16* ot = (u16*)(smem + 16384);
  const float* HYH = (const float*)(ws + OFF_HYH) + ((size_t)l * 8448 + (Lsel ? 8192 : 0) + tch * 64) * 64;
  for (int i = tid; i < 4096; i += 256) hs[i] = HYH[i];
  float w3r[64];
  const float* w3 = p.hy_w3 + (size_t)l * 64 * 1024 + cc * 256 + tid;
#pragma unroll
  for (int j = 0; j < 64; ++j) w3r[j] = w3[j * 1024];
  __syncthreads();
  const int c = tid, o = cc >> 1, dir = cc & 1;
  const float da = -4.605170185988091f / 1.5f, db = -4.605170185988091f / 0.3f;
  const float delta = fabsf(da + (db - da) * ((float)c / 255.0f));
  float ssp = 0.f;
  for (int tt = 0; tt < 64; ++tt) {
    int t = tch * 64 + tt;
    float a = 0.f;
#pragma unroll
    for (int j = 0; j < 64; ++j) a += hs[tt * 64 + j] * w3r[j];
    float tl = (float)t / (float)(L - 1);
    float val = a * expf(-tl * delta);
    if (!(dir == 1 && t == 0)) ssp += val * val;
    ot[c * 66 + tt] = f2bf(val);
  }
  atomicAdd((float*)(ws + OFF_FSS) + ((l * 2 + Lsel) * 2 + o) * 256 + c, ssp);
  __syncthreads();
  u16* dst = Lsel ? (u16*)(ws + OFF_FILTC) : (u16*)(ws + OFF_FILT) + (size_t)l * 2 * 256 * 16384;
  {
    int tt = tid & 63, cg4 = tid >> 6;
    int t = tch * 64 + tt;
    int m = dir ? L - t : L + t;
    if (!(dir == 1 && t == 0)) {
      for (int ci = cg4; ci < 256; ci += 4) dst[(size_t)(o * 256 + ci) * (2 * L) + m] = ot[ci * 66 + tt];
    }
  }
  __syncthreads();
}

__device__ __forceinline__ void inproj_tile(const Params& p, char* smem, int l, int mt, int nt) {
  char* ws = p.ws;
  LAUNDER(ws); LAUNDER(l);
  const u16* HL = (const u16*)(ws + OFF_HL);
  const u16* W = (const u16*)(ws + OFF_WINT) + (size_t)l * 2560 * 1024;
  u16* UL = (u16*)(ws + OFF_UL);
  u16* QROT = (u16*)(ws + OFF_QROT);
  u16* VT = (u16*)(ws + OFF_VT);
  u16* UT = (u16*)(ws + OFF_UT);
  const float* rope = (const float*)(ws + OFF_ROPE);
  auto rowA = [&](int r) { return HL + (size_t)(mt * 256 + r) * 1024; };
  auto rowB = [&](int r) { return W + (size_t)(nt * 128 + r) * 1024; };
  auto epi = [&](f32x4 (&acc)[8][4], int wr, int wc, int fr, int fq) {
    const int colbase = nt * 128 + wc * 64;
    const int rowbase = mt * 256 + wr * 128;
    if (nt < 8) {
      const bool isq = nt < 4;
      const float* nw = (isq ? p.q_norm_w : p.k_norm_w) + l * 64;
      float w4[4];
#pragma unroll
      for (int n = 0; n < 4; ++n) w4[n] = nw[n * 16 + fr] * (isq ? 0.125f : 1.f);
#pragma unroll
      for (int m = 0; m < 8; ++m)
#pragma unroll
        for (int j = 0; j < 4; ++j) {
          float ss = 0.f;
#pragma unroll
          for (int n = 0; n < 4; ++n) ss += acc[m][n][j] * acc[m][n][j];
          ss += __shfl_xor(ss, 1); ss += __shfl_xor(ss, 2); ss += __shfl_xor(ss, 4); ss += __shfl_xor(ss, 8);
          float rstd = rsqrtf(ss * (1.f / 64.f) + EPSF);
          int row = rowbase + m * 16 + fq * 4 + j;
          float v[4];
#pragma unroll
          for (int n = 0; n < 4; ++n) v[n] = acc[m][n][j] * rstd * w4[n];
          bool lat = row < MLAT;
          float rv[4] = {v[0], v[1], v[2], v[3]};
          if (lat) {
            int t = row & 8191, pr = t >> 6, pc = t & 63;
            float c0 = rope[pr * 16 + fr], s0 = rope[2048 + pr * 16 + fr];
            float c1 = rope[pc * 16 + fr], s1 = rope[2048 + pc * 16 + fr];
            rv[0] = v[0] * c0 - v[1] * s0; rv[1] = v[1] * c0 + v[0] * s0;
            rv[2] = v[2] * c1 - v[3] * s1; rv[3] = v[3] * c1 + v[2] * s1;
          }
          if (isq) {
#pragma unroll
            for (int n = 0; n < 4; ++n) UL[(size_t)row * 2560 + colbase + n * 16 + fr] = f2bf(v[n]);
            if (lat) {
#pragma unroll
              for (int n = 0; n < 4; ++n) QROT[(size_t)row * 512 + colbase + n * 16 + fr] = f2bf(rv[n]);
            }
          } else {
#pragma unroll
            for (int n = 0; n < 4; ++n) UL[(size_t)row * 2560 + colbase + n * 16 + fr] = f2bf(rv[n]);
          }
        }
    } else if (nt < 18) {
      u16* T = nt < 12 ? VT : UT;
      const int cb = colbase - (nt < 12 ? 1024 : 1536);
#pragma unroll
      for (int m = 0; m < 8; ++m)
#pragma unroll
        for (int n = 0; n < 4; ++n) {
          uint2 o; o.x = pack2(acc[m][n][0], acc[m][n][1]); o.y = pack2(acc[m][n][2], acc[m][n][3]);
          *(uint2*)&T[(size_t)(cb + n * 16 + fr) * MTOT + rowbase + m * 16 + fq * 4] = o;
        }
    } else {
#pragma unroll
      for (int m = 0; m < 8; ++m)
#pragma unroll
        for (int n = 0; n < 4; ++n)
#pragma unroll
          for (int j = 0; j < 4; ++j)
            UL[(size_t)(rowbase + m * 16 + fq * 4 + j) * 2560 + colbase + n * 16 + fr] = f2bf(acc[m][n][j]);
    }
  };
  gemm_tile<1024>(smem, 256, rowA, rowB, epi);
}

__device__ __forceinline__ void hyena_lat_job(const Params& p, char* smem, int l, int c) {
  const int tid = vtid(), lane = tid & 63, w = __builtin_amdgcn_readfirstlane(tid >> 6), r = lane & 31, h = lane >> 5;
  char* ws = p.ws;
  LAUNDER(ws); LAUNDER(l);
  u16* zs = (u16*)smem;
  u16* Es = (u16*)(smem + 40960);
  u16* Fs = (u16*)(smem + 40960 + 18688);
  const u16* UT = (const u16*)(ws + OFF_UT);
  u16* MIX = (u16*)(ws + OFF_MIX);
  const float* cw = p.hy_conv_w + l * 3 * 768;
  const float* cb = p.hy_conv_b + l * 768;
  __syncthreads();
  {
    int gc = 512 + c;
    float w0 = cw[gc], w1 = cw[768 + gc], w2 = cw[1536 + gc], bb = cb[gc];
    const u16* u = UT + (size_t)gc * MTOT;
    if (tid < 4) *(unsigned*)&zs[32 + tid * 2] = 0u;
    for (int i4 = tid; i4 < 4096; i4 += 256) {
      int i = i4 * 4;
      int b = i >> 13, t = i & 8191;
      uint2 mid = *(const uint2*)&u[i];
      float um = t > 0 ? bf2f(u[i - 1]) : 0.f, up = t + 4 < 8192 ? bf2f(u[i + 4]) : 0.f;
      float e0 = __uint_as_float(mid.x << 16), e1 = __uint_as_float(mid.x & 0xffff0000u);
      float e2 = __uint_as_float(mid.y << 16), e3 = __uint_as_float(mid.y & 0xffff0000u);
      float z0 = bb + w0 * um + w1 * e0 + w2 * e1;
      float z1 = bb + w0 * e0 + w1 * e1 + w2 * e2;
      float z2 = bb + w0 * e1 + w1 * e2 + w2 * e3;
      float z3 = bb + w0 * e2 + w1 * e3 + w2 * up;
      uint2 o; o.x = pack2(z0, z1); o.y = pack2(z2, z3);
      *(uint2*)&zs[b * 10240 + (t >> 5) * 40 + (t & 31)] = o;
    }
  }
  const int b = r >> 4, ib = 16 * w + (r & 15);
  const unsigned zs_lds = (unsigned)(uintptr_t)(__attribute__((address_space(3))) char*)(char*)zs;
  const int be = r - 8 * h + 8;
  const unsigned es_lds = (unsigned)(uintptr_t)(__attribute__((address_space(3))) char*)(char*)Es;
  const unsigned eb_al = es_lds + (unsigned)((be & ~7) * 16);
  unsigned exo[4];
#pragma unroll
  for (int k = 0; k < 4; ++k) exo[k] = (unsigned)((((be & 7) ^ (((be >> 3) + 2 * k) & 7))) * 16);
  const int sig_lo = 128 * w - 511, sig_hi = 128 * w + 120;
  for (int o = 0; o < 2; ++o) {
    const u16* filt = (const u16*)(ws + OFF_FILT) + ((size_t)((l * 2 + o) * 256 + c)) * 16384;
    f32x16 acc[4];
#pragma unroll
    for (int m = 0; m < 4; ++m)
#pragma unroll
      for (int q = 0; q < 16; ++q) acc[m][q] = 0.f;
    u16 pfv[5];
#pragma unroll
    for (int q = 0; q < 5; ++q) {
      int idx = 16 * (-512) - 8 + 8192 - 7 + tid + 256 * q;
      idx = idx < 0 ? 0 : (idx > 16383 ? 16383 : idx);
      pfv[q] = filt[idx];
    }
    for (int ch = 0; ch < 16; ++ch) {
      const int sc = -512 + ch * 64;
      const int mbase = 16 * sc - 8;
      __syncthreads();
#pragma unroll
      for (int q = 0; q < 5; ++q) { int e = tid + 256 * q; if (e < 1176) Fs[e] = pfv[q]; }
      __syncthreads();
      if (tid < 146) {
        const uint4 lo = *(const uint4*)&Fs[8 * tid], hi = *(const uint4*)&Fs[8 * tid + 8];
        const unsigned W[8] = {lo.x, lo.y, lo.z, lo.w, hi.x, hi.y, hi.z, hi.w};
#pragma unroll
        for (int i = 0; i < 8; ++i) {
          unsigned dw[4];
#pragma unroll
          for (int d = 0; d < 4; ++d) {
            if ((i & 1) == 0) { const unsigned w_ = W[i / 2 + 3 - d]; dw[d] = (w_ >> 16) | (w_ << 16); }
            else { const int k_ = (i - 1) / 2 + 3 - d; dw[d] = (W[k_ + 1] & 0xffffu) | (W[k_] & 0xffff0000u); }
          }
          *(uint4*)&Es[(8 * tid + (i ^ (tid & 7))) * 8] = make_uint4(dw[0], dw[1], dw[2], dw[3]);
        }
      }
      __syncthreads();
      if (ch + 1 < 16) {
#pragma unroll
        for (int q = 0; q < 5; ++q) {
          int idx = mbase + 1024 + 8192 - 7 + tid + 256 * q;
          idx = idx < 0 ? 0 : (idx > 16383 ? 16383 : idx);
          pfv[q] = filt[idx];
        }
      }
      bf16x8 ring[8];
#pragma unroll
      for (int u = 0; u < 8; ++u) {
        const int k_ = u < 7 ? u : 0;
        ring[u] = *(const bf16x8*)((const char*)Es + ((be & ~7) + 16 * k_) * 16 + exo[k_ & 3]);
      }
      bf16x8 bq0, bq1;
      {
        int S = 8 * ib - sc;
        int za = (S >= 0 && S < 512) ? b * 10240 + (S >> 1) * 40 + (S & 1) * 16 + 8 * h : 32;
        bq0 = *(const bf16x8*)&zs[za];
        bq1 = bq0;
      }
#define DS_READ128(dst, addr) asm volatile("ds_read_b128 %0, %1" : "=v"(dst) : "v"(addr))
#define HY_STEP(U, BCUR, BNEXT)                                                                              \
  {                                                                                                          \
    const int sl = g8 * 8 + (U);                                                                             \
    const int sg = sc + sl;                                                                                  \
    const unsigned ea = eb_al + 256u * (unsigned)(sl + 7) + exo[((U) + 7) & 3];                              \
    const int S_ = 8 * ib - sg - 1;                                                                          \
    const unsigned za_ = zs_lds + 2u * (unsigned)((S_ >= 0 && S_ < 512) ? b * 10240 + (S_ >> 1) * 40 + (S_ & 1) * 16 + 8 * h : 32); \
    DS_READ128(ring[((U) + 7) & 7], ea);                                                                     \
    DS_READ128(BNEXT, za_);                                                                                  \
    asm volatile("s_waitcnt lgkmcnt(2)" : "+v"(BCUR), "+v"(ring[((U) + 6) & 7]));                           \
    if (sg >= sig_lo && sg <= sig_hi) {                                                                      \
      acc[0] = __builtin_amdgcn_mfma_f32_32x32x16_bf16(ring[(U)], BCUR, acc[0], 0, 0, 0);                    \
      acc[1] = __builtin_amdgcn_mfma_f32_32x32x16_bf16(ring[((U) + 2) & 7], BCUR, acc[1], 0, 0, 0);          \
      acc[2] = __builtin_amdgcn_mfma_f32_32x32x16_bf16(ring[((U) + 4) & 7], BCUR, acc[2], 0, 0, 0);          \
      acc[3] = __builtin_amdgcn_mfma_f32_32x32x16_bf16(ring[((U) + 6) & 7], BCUR, acc[3], 0, 0, 0);          \
    }                                                                                                        \
    __builtin_amdgcn_sched_barrier(0);                                                                       \
  }
      for (int g8 = 0; g8 < 8; ++g8) {
        HY_STEP(0, bq0, bq1) HY_STEP(1, bq1, bq0) HY_STEP(2, bq0, bq1) HY_STEP(3, bq1, bq0)
        HY_STEP(4, bq0, bq1) HY_STEP(5, bq1, bq0) HY_STEP(6, bq0, bq1) HY_STEP(7, bq1, bq0)
      }
      asm volatile("s_waitcnt lgkmcnt(0)" ::: "memory");
#undef HY_STEP
#undef DS_READ128
    }
    const float scale = rsqrtf(((const float*)(ws + OFF_FSS))[((l * 2 + 0) * 2 + o) * 256 + c] + EPSF);
    const float skip = p.hy_skip[(l * 2 + o) * 256 + c];
    const int gc = o * 256 + c;
    const float w0 = cw[gc], w1 = cw[768 + gc], w2 = cw[1536 + gc], bb = cb[gc];
    const u16* u = UT + (size_t)gc * MTOT + b * 8192;
    __syncthreads();
    int tb = 128 * ib + 4 * h;
    asm volatile("" : "+v"(tb));
#pragma unroll
    for (int mt = 0; mt < 4; ++mt)
#pragma unroll
      for (int g = 0; g < 4; ++g) {
        int t0 = tb + 32 * mt + 8 * g;
        float uu[6];
        {
          const uint2 mid = *(const uint2*)&u[t0];
          uu[0] = t0 > 0 ? bf2f(u[t0 - 1]) : 0.f;
          uu[1] = __uint_as_float(mid.x << 16); uu[2] = __uint_as_float(mid.x & 0xffff0000u);
          uu[3] = __uint_as_float(mid.y << 16); uu[4] = __uint_as_float(mid.y & 0xffff0000u);
          uu[5] = t0 + 4 < 8192 ? bf2f(u[t0 + 4]) : 0.f;
        }
        const int zi0 = b * 10240 + (t0 >> 5) * 40 + (t0 & 31);
        const uint2 zo = *(const uint2*)&zs[zi0];
        float zold4[4] = {__uint_as_float(zo.x << 16), __uint_as_float(zo.x & 0xffff0000u),
                          __uint_as_float(zo.y << 16), __uint_as_float(zo.y & 0xffff0000u)};
        float zn4[4];
#pragma unroll
        for (int q = 0; q < 4; ++q) {
          float gate = bb + w0 * uu[q] + w1 * uu[q + 1] + w2 * uu[q + 2];
          zn4[q] = gate * (scale * acc[mt][g * 4 + q] + zold4[q] * skip);
        }
        if (o == 0) {
          uint2 zw; zw.x = pack2(zn4[0], zn4[1]); zw.y = pack2(zn4[2], zn4[3]);
          *(uint2*)&zs[zi0] = zw;
        } else {
#pragma unroll
          for (int q = 0; q < 4; ++q) MIX[(size_t)(b * 8192 + t0 + q) * 1024 + 512 + c] = f2bf(zn4[q]);
        }
      }
  }
  __syncthreads();
}

__device__ __forceinline__ void hyena_ctx_job(const Params& p, char* smem, int job) {
  const int tid = vtid();
  char* ws = p.ws;
  LAUNDER(ws);
  float* zf = (float*)smem;
  float* kf = zf + 512;
  const u16* UT = (const u16*)(ws + OFF_UT);
  u16* MIX = (u16*)(ws + OFF_MIX);
  const float* cw = p.hy_conv_w;
  const float* cb = p.hy_conv_b;
  for (int cc = 0; cc < 8; ++cc) {
    const int c = job * 8 + cc;
    __syncthreads();
    for (int i = tid; i < 1024; i += 256) {
      int o = i >> 9, m = i & 511;
      float scale = rsqrtf(((const float*)(ws + OFF_FSS))[((0 * 2 + 1) * 2 + o) * 256 + c] + EPSF);
      float kv = (m == 0) ? 0.f : bf2f(((const u16*)(ws + OFF_FILTC))[(size_t)(o * 256 + c) * 512 + m]);
      kf[i] = kv * scale;
    }
    {
      int gc = 512 + c;
      float w0 = cw[gc], w1 = cw[768 + gc], w2 = cw[1536 + gc], bb = cb[gc];
      for (int i = tid; i < 512; i += 256) {
        int b = i >> 8, t = i & 255;
        const u16* u = UT + (size_t)gc * MTOT + MLAT + b * 256;
        float um = t > 0 ? bf2f(u[t - 1]) : 0.f, u0 = bf2f(u[t]), up = t < 255 ? bf2f(u[t + 1]) : 0.f;
        zf[i] = bb + w0 * um + w1 * u0 + w2 * up;
      }
    }
    __syncthreads();
    for (int o = 0; o < 2; ++o) {
      int gc = o * 256 + c;
      float w0 = cw[gc], w1 = cw[768 + gc], w2 = cw[1536 + gc], bb = cb[gc];
      float skip = p.hy_skip[(0 * 2 + o) * 256 + c];
      float zn[2];
#pragma unroll
      for (int q = 0; q < 2; ++q) {
        int i = tid + 256 * q;
        int b = i >> 8, t = i & 255;
        float y = 0.f;
        for (int s = 0; s < 256; ++s) y += kf[o * 512 + t - s + 256] * zf[b * 256 + s];
        const u16* u = UT + (size_t)gc * MTOT + MLAT + b * 256;
        float um = t > 0 ? bf2f(u[t - 1]) : 0.f, u0 = bf2f(u[t]), up = t < 255 ? bf2f(u[t + 1]) : 0.f;
        float gate = bb + w0 * um + w1 * u0 + w2 * up;
        zn[q] = gate * (y + zf[i] * skip);
      }
      __syncthreads();
#pragma unroll
      for (int q = 0; q < 2; ++q) {
        int i = tid + 256 * q;
        if (o == 0) zf[i] = zn[q];
        else {
          int b = i >> 8, t = i & 255;
          MIX[(size_t)(MLAT + b * 256 + t) * 1024 + 512 + c] = f2bf(zn[q]);
        }
      }
      __syncthreads();
    }
  }
}

__device__ __forceinline__ void attn_job(const Params& p, char* smem, int l, int b, int qrow0, int hp, int r) {
  const int tid = vtid(), lane = tid & 63, w = tid >> 6;
  char* ws = p.ws;
  LAUNDER(ws); LAUNDER(l);
  u16* Ks = (u16*)smem;
  u16* Vs = (u16*)(smem + 18432);
  float* rp = (float*)(smem + 36864);
  const u16* UL = (const u16*)(ws + OFF_UL);
  const u16* QROT = (const u16*)(ws + OFF_QROT);
  const u16* VT = (const u16*)(ws + OFF_VT);
  u16* MIX = (u16*)(ws + OFF_MIX);
  const int hl = w >> 1, qh = w & 1, head = 2 * hp + hl, ql = lane & 31, h5 = lane >> 5, qc = 32 * qh + ql;
  const bool lat = r >= 0;
  int rs = r - 4; rs = rs < 0 ? 0 : (rs > 120 ? 120 : rs);
  __syncthreads();
  if (lat) {
    for (int i = tid; i < 930; i += 256) {
      int h2 = i / 465, k = i % 465;
      rp[h2 * 480 + k] = p.na_rpb[(size_t)((l * 8 + 2 * hp + h2) * 465) + k];
    }
  }
  const int qrow = qrow0 + qc;
  bf16x8 qp[4], qr[4];
#pragma unroll
  for (int ks = 0; ks < 4; ++ks) {
    qp[ks] = *(const bf16x8*)&UL[(size_t)qrow * 2560 + head * 64 + 16 * ks + 8 * h5];
    qr[ks] = lat ? *(const bf16x8*)&QROT[(size_t)qrow * 512 + head * 64 + 16 * ks + 8 * h5] : qp[ks];
  }
  f32x16 ot[2];
#pragma unroll
  for (int d = 0; d < 2; ++d)
#pragma unroll
    for (int q = 0; q < 16; ++q) ot[d][q] = 0.f;
  float mrun = -1e30f, lrun = 0.f;
  int cs = qc - 8; cs = cs < 0 ? 0 : (cs > 48 ? 48 : cs);
#define ATT_LD(i, PK, PV, KR0)                                                                       \
  {                                                                                                 \
    int q_ = tid + 256 * (i);                                                                       \
    int h2_ = q_ >> 9, key_ = (q_ >> 3) & 63, seg_ = q_ & 7;                                        \
    PK = *(const uint4*)&UL[(size_t)((KR0) + key_) * 2560 + 512 + (2 * hp + h2_) * 64 + seg_ * 8]; \
    PV = *(const uint4*)&VT[(size_t)((2 * hp + h2_) * 64 + key_) * MTOT + (KR0) + seg_ * 8];       \
  }
#define ATT_ST(i, PK, PV)                                                \
  {                                                                      \
    int q_ = tid + 256 * (i);                                            \
    int h2_ = q_ >> 9, key_ = (q_ >> 3) & 63, seg_ = q_ & 7;             \
    *(uint4*)&Ks[(h2_ * 64 + key_) * 72 + seg_ * 8] = PK;                \
    *(uint4*)&Vs[(h2_ * 64 + key_) * 72 + seg_ * 8] = PV;                \
  }
  uint4 pk0, pk1, pk2, pk3, pv0, pv1, pv2, pv3;
  {
    const int ci = lat ? 0 : 8;
    const int keyrow0 = ci < 8 ? b * 8192 + (rs + ci) * 64 : MLAT + b * 256 + (ci - 8) * 64;
    ATT_LD(0, pk0, pv0, keyrow0) ATT_LD(1, pk1, pv1, keyrow0) ATT_LD(2, pk2, pv2, keyrow0) ATT_LD(3, pk3, pv3, keyrow0)
  }
  for (int ci = lat ? 0 : 8; ci < 12; ++ci) {
    __syncthreads();
    ATT_ST(0, pk0, pv0) ATT_ST(1, pk1, pv1) ATT_ST(2, pk2, pv2) ATT_ST(3, pk3, pv3)
    __syncthreads();
    if (ci + 1 < 12) {
      const int cn = ci + 1;
      const int keyrow0 = cn < 8 ? b * 8192 + (rs + cn) * 64 : MLAT + b * 256 + (cn - 8) * 64;
      ATT_LD(0, pk0, pv0, keyrow0) ATT_LD(1, pk1, pv1, keyrow0) ATT_LD(2, pk2, pv2, keyrow0) ATT_LD(3, pk3, pv3, keyrow0)
    }
    f32x16 st[2];
#pragma unroll
    for (int mt = 0; mt < 2; ++mt) {
#pragma unroll
      for (int q = 0; q < 16; ++q) st[mt][q] = 0.f;
#pragma unroll
      for (int ks = 0; ks < 4; ++ks) {
        bf16x8 a = *(const bf16x8*)&Ks[(hl * 64 + 32 * mt + ql) * 72 + 16 * ks + 8 * h5];
        st[mt] = __builtin_amdgcn_mfma_f32_32x32x16_bf16(a, ci < 8 ? qr[ks] : qp[ks], st[mt], 0, 0, 0);
      }
    }
    if (ci < 8) {
      const int rb = (rs + ci - r + 7) * 31;
#pragma unroll
      for (int mt = 0; mt < 2; ++mt)
#pragma unroll
        for (int q = 0; q < 16; ++q) {
          int kc = 32 * mt + (q & 3) + 8 * (q >> 2) + 4 * h5;
          int dd = kc - cs;
          bool valid = dd >= 0 && dd < 16;
          float bias = rp[hl * 480 + (valid ? rb + kc - qc + 15 : 0)];
          st[mt][q] = valid ? st[mt][q] + bias : -1e30f;
        }
    }
    float mx = -1e30f;
#pragma unroll
    for (int mt = 0; mt < 2; ++mt)
#pragma unroll
      for (int q = 0; q < 16; ++q) mx = fmaxf(mx, st[mt][q]);
    mx = fmaxf(mx, __shfl_xor(mx, 32));
    const float mnew = fmaxf(mrun, mx);
    const float alpha = __expf(mrun - mnew);
    float ps = 0.f;
#pragma unroll
    for (int mt = 0; mt < 2; ++mt)
#pragma unroll
      for (int q = 0; q < 16; ++q) {
        float pv = __expf(st[mt][q] - mnew);
        st[mt][q] = pv;
        ps += pv;
      }
    lrun = lrun * alpha + ps;
    mrun = mnew;
#pragma unroll
    for (int d = 0; d < 2; ++d)
#pragma unroll
      for (int q = 0; q < 16; ++q) ot[d][q] *= alpha;
    bf16x8 pf[4];
#pragma unroll
    for (int mt = 0; mt < 2; ++mt)
#pragma unroll
      for (int s = 0; s < 2; ++s) {
        uint4 t4;
        t4.x = pack2(st[mt][8 * s + 0], st[mt][8 * s + 1]);
        t4.y = pack2(st[mt][8 * s + 2], st[mt][8 * s + 3]);
        t4.z = pack2(st[mt][8 * s + 4], st[mt][8 * s + 5]);
        t4.w = pack2(st[mt][8 * s + 6], st[mt][8 * s + 7]);
        pf[2 * mt + s] = *(bf16x8*)&t4;
      }
#pragma unroll
    for (int dt = 0; dt < 2; ++dt)
#pragma unroll
      for (int kst = 0; kst < 4; ++kst) {
        const u16* vb = &Vs[(hl * 64 + 32 * dt + ql) * 72 + 16 * kst + 4 * h5];
        uint2 lo = *(const uint2*)vb;
        uint2 hi = *(const uint2*)(vb + 8);
        uint4 t4; t4.x = lo.x; t4.y = lo.y; t4.z = hi.x; t4.w = hi.y;
        ot[dt] = __builtin_amdgcn_mfma_f32_32x32x16_bf16(*(bf16x8*)&t4, pf[kst], ot[dt], 0, 0, 0);
      }
  }
  const float ltot = lrun + __shfl_xor(lrun, 32);
  const float inv = 1.f / ltot;
#pragma unroll
  for (int dt = 0; dt < 2; ++dt)
#pragma unroll
    for (int g = 0; g < 4; ++g) {
      int dim0 = 32 * dt + 8 * g + 4 * h5;
      uint2 o2;
      o2.x = pack2(ot[dt][4 * g + 0] * inv, ot[dt][4 * g + 1] * inv);
      o2.y = pack2(ot[dt][4 * g + 2] * inv, ot[dt][4 * g + 3] * inv);
      *(uint2*)&MIX[(size_t)qrow * 1024 + head * 64 + dim0] = o2;
    }
  __syncthreads();
}

__device__ __forceinline__ void pool_job(const Params& p, char* smem, int l, int seqrow0, int L, int t0) {
  const int tid = vtid();
  char* ws = p.ws;
  LAUNDER(ws); LAUNDER(l);
  u16* us = (u16*)smem;
  float* ds = (float*)(smem + 24576);
  const u16* UL = (const u16*)(ws + OFF_UL);
  u16* MIX = (u16*)(ws + OFF_MIX);
  __syncthreads();
  for (int q = tid; q < 48 * 32; q += 256) {
    int rr = q >> 5, seg = q & 31;
    int t = t0 - 8 + rr;
    uint4 v = make_uint4(0, 0, 0, 0);
    if (t >= 0 && t < L) v = *(const uint4*)&UL[(size_t)(seqrow0 + t) * 2560 + 2304 + seg * 8];
    *(uint4*)&us[rr * 256 + seg * 8] = v;
  }
  __syncthreads();
  {
    const int ch = tid, g = ch >> 6, wdt = 2 << g;
    for (int tt = 0; tt < 32; ++tt) {
      int t = t0 + tt;
      int lo = t - wdt / 2, hi = lo + wdt;
      lo = lo < 0 ? 0 : lo; hi = hi > L ? L : hi;
      float s = 0.f;
      for (int pp = lo; pp < hi; ++pp) s += bf2f(us[(pp - t0 + 8) * 256 + ch]);
      float mean = s / (float)(hi - lo);
      ds[tt * 256 + ch] = mean - bf2f(us[(tt + 8) * 256 + ch]);
    }
  }
  __syncthreads();
  {
    const int g = tid >> 6, j = tid & 63;
    const float* pw = p.pool_w + (size_t)(l * 4 + g) * 4096;
    float acc[32];
#pragma unroll
    for (int tt = 0; tt < 32; ++tt) acc[tt] = 0.f;
    for (int cch = 0; cch < 64; ++cch) {
      float wv = pw[cch * 64 + j];
#pragma unroll
      for (int tt = 0; tt < 32; ++tt) acc[tt] += ds[tt * 256 + g * 64 + cch] * wv;
    }
    float sc = p.pool_scale[l * 256 + tid];
#pragma unroll
    for (int tt = 0; tt < 32; ++tt) MIX[(size_t)(seqrow0 + t0 + tt) * 1024 + 768 + tid] = f2bf(acc[tt] * sc);
  }
  __syncthreads();
}

__device__ __forceinline__ void outproj_tile(const Params& p, char* smem, int l, int mt, int nt, int ks) {
  char* ws = p.ws;
  LAUNDER(ws); LAUNDER(l);
  const u16* MIX = (const u16*)(ws + OFF_MIX);
  const u16* W = (const u16*)(ws + OFF_WOUTT) + (size_t)l * 1024 * 1024;
  float* XN = (float*)(ws + OFF_XNEW);
  const float* MODS = (const float*)(ws + OFF_MODS);
  const int koff = ks < 0 ? 0 : ks * 256;
  auto rowA = [&](int r) { return MIX + (size_t)(mt * 256 + r) * 1024 + koff; };
  auto rowB = [&](int r) { return W + (size_t)(nt * 128 + r) * 1024 + koff; };
  auto epi = [&](f32x4 (&acc)[8][4], int wr, int wc, int fr, int fq) {
    const int row0 = mt * 256;
    const int v = row0 < MLAT ? (row0 >> 13) : 2;
    float* O = l == 0 ? XN : p.out;
    float gv[4];
#pragma unroll
    for (int n = 0; n < 4; ++n) gv[n] = MODS[(l * 3 + v) * 6144 + 2048 + nt * 128 + wc * 64 + n * 16 + fr];
#pragma unroll
    for (int m = 0; m < 8; ++m)
#pragma unroll
      for (int j = 0; j < 4; ++j) {
        int row = row0 + wr * 128 + m * 16 + fq * 4 + j;
        float* orow = O + (size_t)row * 1024 + nt * 128 + wc * 64 + fr;
#pragma unroll
        for (int n = 0; n < 4; ++n) unsafeAtomicAdd(orow + n * 16, gv[n] * acc[m][n][j]);
      }
  };
  if (ks < 0) gemm_tile<1024>(smem, 256, rowA, rowB, epi);
  else gemm_tile<256>(smem, 256, rowA, rowB, epi);
}

__device__ __forceinline__ void router_rows(const Params& p, char* smem, int l, int nrows) {
  const int tid = vtid(), lane = tid & 63, wid = tid >> 6;
  char* ws = p.ws;
  LAUNDER(ws); LAUNDER(l);
  const float* XR = l == 0 ? (const float*)(ws + OFF_XNEW) : p.out;
  u16* H2 = (u16*)(ws + OFF_H2);
  const float* nw = p.norm2_w + l * 1024;
  const float* wr = p.w_router + (size_t)l * 1024 * 16;
  float* Hs = (float*)smem;
  float* red = Hs + 256 * 36;
  const int ngroups = nrows >> 3;
  for (int grp = blockIdx.x; grp < ngroups; grp += gridDim.x) {
    __syncthreads();
#pragma unroll
    for (int rr = 0; rr < 2; ++rr) {
      const int rl = wid * 2 + rr;
      const int row = grp * 8 + rl;
      const float* src = XR + (size_t)row * 1024;
      int v = row < MLAT ? (row >> 13) : 2;
      const float* mods = (const float*)(ws + OFF_MODS) + (l * 3 + v) * 6144;
      float4 xv[4];
      float ss = 0.f;
#pragma unroll
      for (int q = 0; q < 4; ++q) {
        xv[q] = *(const float4*)&src[lane * 4 + 256 * q];
        ss += xv[q].x * xv[q].x + xv[q].y * xv[q].y + xv[q].z * xv[q].z + xv[q].w * xv[q].w;
      }
      ss = wave_sum(ss);
      float rstd = rsqrtf(ss * (1.f / 1024.f) + EPSF);
#pragma unroll
      for (int q = 0; q < 4; ++q) {
        int col = lane * 4 + 256 * q;
        float4 w = *(const float4*)&nw[col];
        float4 sh = *(const float4*)&mods[3072 + col];
        float4 sc = *(const float4*)&mods[4096 + col];
        float h0 = xv[q].x * rstd * w.x * (1.f + sc.x) + sh.x;
        float h1 = xv[q].y * rstd * w.y * (1.f + sc.y) + sh.y;
        float h2 = xv[q].z * rstd * w.z * (1.f + sc.z) + sh.z;
        float h3 = xv[q].w * rstd * w.w * (1.f + sc.w) + sh.w;
        uint2 o; o.x = pack2(h0, h1); o.y = pack2(h2, h3);
        *(uint2*)&H2[(size_t)row * 1024 + col] = o;
        *(float4*)&Hs[(col >> 2) * 36 + rl * 4] = make_float4(h0, h1, h2, h3);
      }
    }
    __syncthreads();
    {
      const int e = tid & 15, ks = tid >> 4;
      float acc[8];
#pragma unroll
      for (int r = 0; r < 8; ++r) acc[r] = 0.f;
      const float* wp = wr + (size_t)(ks * 64) * 16 + e;
      const float* hp = Hs + (ks * 16) * 36;
#pragma unroll 2
      for (int kg = 0; kg < 16; ++kg) {
        const float w0 = wp[(kg * 4 + 0) * 16], w1 = wp[(kg * 4 + 1) * 16], w2 = wp[(kg * 4 + 2) * 16], w3 = wp[(kg * 4 + 3) * 16];
#pragma unroll
        for (int r = 0; r < 8; ++r) {
          const float4 hv = *(const float4*)&hp[kg * 36 + r * 4];
          acc[r] += hv.x * w0 + hv.y * w1 + hv.z * w2 + hv.w * w3;
        }
      }
#pragma unroll
      for (int r = 0; r < 8; ++r) {
        acc[r] += __shfl_xor(acc[r], 16);
        acc[r] += __shfl_xor(acc[r], 32);
      }
      if (lane < 16) {
#pragma unroll
        for (int r = 0; r < 8; ++r) red[(wid * 8 + r) * 16 + lane] = acc[r];
      }
    }
    __syncthreads();
    if (tid < 128) {
      const int r = tid >> 4, e = tid & 15;
      float lg = red[(0 * 8 + r) * 16 + e] + red[(1 * 8 + r) * 16 + e] + red[(2 * 8 + r) * 16 + e] + red[(3 * 8 + r) * 16 + e];
      float mx = lg;
      mx = fmaxf(mx, __shfl_xor(mx, 1)); mx = fmaxf(mx, __shfl_xor(mx, 2));
      mx = fmaxf(mx, __shfl_xor(mx, 4)); mx = fmaxf(mx, __shfl_xor(mx, 8));
      float ex = expf(lg - mx);
      float sm = ex;
      sm += __shfl_xor(sm, 1); sm += __shfl_xor(sm, 2); sm += __shfl_xor(sm, 4); sm += __shfl_xor(sm, 8);
      float aff = ex / sm;
      const int row = grp * 8 + r;
      if (row < MLAT) ((float*)(ws + OFF_AFF))[((size_t)(row >> 13) * 16 + e) * 8192 + (row & 8191)] = aff;
      else { int rc = row - MLAT; ((float*)(ws + OFF_AFFC))[((size_t)(rc >> 8) * 16 + e) * 256 + (rc & 255)] = aff; }
    }
  }
  __syncthreads();
}

template <int NV>
__device__ __forceinline__ void topk_body(char* smem, const unsigned* A, int* oi, float* og, int cap) {
  const int tid = vtid(), lane = tid & 63, wid = tid >> 6;
  int* red = (int*)smem;
  unsigned v[NV];
#pragma unroll
  for (int q = 0; q < NV; ++q) v[q] = A[tid + 256 * q];
  __syncthreads();
  unsigned T = 0;
  for (int bit = 30; bit >= 0; --bit) {
    const unsigned cand = T | (1u << bit);
    int c = 0;
#pragma unroll
    for (int q = 0; q < NV; ++q) c += (v[q] >= cand) ? 1 : 0;
#pragma unroll
    for (int o = 32; o > 0; o >>= 1) c += __shfl_xor(c, o);
    int* rb = red + (bit & 1) * 4;
    if (lane == 0) rb[wid] = c;
    __syncthreads();
    int tot = rb[0] + rb[1] + rb[2] + rb[3];
    if (tot >= cap) T = cand;
  }
  int cg = 0, ce = 0;
#pragma unroll
  for (int q = 0; q < NV; ++q) { cg += (v[q] > T) ? 1 : 0; ce += (v[q] == T) ? 1 : 0; }
  int sg = cg, se = ce;
#pragma unroll
  for (int o = 1; o < 64; o <<= 1) {
    int tg = __shfl_up(sg, o), te = __shfl_up(se, o);
    if (lane >= o) { sg += tg; se += te; }
  }
  __syncthreads();
  int* ws4 = red + 16;
  if (lane == 63) { ws4[wid] = sg; ws4[4 + wid] = se; }
  __syncthreads();
  int baseg = 0, basee = 0, totg = 0;
#pragma unroll
  for (int w = 0; w < 4; ++w) {
    int a = ws4[w], e = ws4[4 + w];
    if (w < wid) { baseg += a; basee += e; }
    totg += a;
  }
  int pg = baseg + sg - cg, pe = basee + se - ce;
  const int krem = cap - totg;
#pragma unroll
  for (int q = 0; q < NV; ++q) {
    int slot = -1;
    if (v[q] > T) slot = pg++;
    else if (v[q] == T) { int tr = pe++; if (tr < krem) slot = totg + tr; }
    if (slot >= 0 && slot < cap) { oi[slot] = tid + 256 * q; og[slot] = __uint_as_float(v[q]); }
  }
  __syncthreads();
}

__device__ __forceinline__ void topk_job(const Params& p, char* smem, int je, bool isctx) {
  char* ws = p.ws;
  LAUNDER(ws);
  if (!isctx)
    topk_body<32>(smem, (const unsigned*)(ws + OFF_AFF) + (size_t)je * 8192, (int*)(ws + OFF_SELI) + je * 1024,
                  (float*)(ws + OFF_SELG) + je * 1024, 1024);
  else
    topk_body<1>(smem, (const unsigned*)(ws + OFF_AFFC) + (size_t)je * 256, (int*)(ws + OFF_SELIC) + je * 32,
                 (float*)(ws + OFF_SELGC) + je * 32, 32);
}

__device__ __forceinline__ void moe_up_tile(const Params& p, char* smem, int l, int e, int nt, int b, int mt, bool isctx) {
  char* ws = p.ws;
  LAUNDER(ws); LAUNDER(l);
  const u16* H2 = (const u16*)(ws + OFF_H2);
  const u16* W = (const u16*)(ws + OFF_WGUT) + (size_t)(l * 16 + e) * 4096 * 1024;
  const int* idxL = (const int*)(ws + OFF_SELI) + (b * 16 + e) * 1024 + mt * 256;
  const int* idxC = (const int*)(ws + OFF_SELIC);
  u16* ACTL = (u16*)(ws + OFF_ACT) + ((size_t)(b * 16 + e) * 1024 + mt * 256) * 2048;
  u16* ACTC = (u16*)(ws + OFF_ACTC);
  const int nvalid = isctx ? 64 : 256;
  auto rowA = [&](int r) {
    int row;
    if (isctx) { int s_ = r < 64 ? r : 0; int bb = s_ >> 5; row = MLAT + bb * 256 + idxC[(bb * 16 + e) * 32 + (s_ & 31)]; }
    else row = b * 8192 + idxL[r];
    return H2 + (size_t)row * 1024;
  };
  auto rowB = [&](int r) { return W + (size_t)(nt * 128 + r) * 1024; };
  auto epi = [&](f32x4 (&acc)[8][4], int wr, int wc, int fr, int fq) {
#pragma unroll
    for (int m = 0; m < 8; ++m)
#pragma unroll
      for (int j = 0; j < 4; ++j) {
        int slot = wr * 128 + m * 16 + fq * 4 + j;
        if (slot < nvalid) {
          u16* dst = isctx ? ACTC + ((size_t)(((slot >> 5) * 16 + e) * 32 + (slot & 31))) * 2048 : ACTL + (size_t)slot * 2048;
#pragma unroll
          for (int n = 0; n < 2; ++n) {
            int f = nt * 64 + wc * 32 + n * 16 + fr;
            float g = acc[m][n][j], uu = acc[m][n + 2][j];
            dst[f] = f2bf(siluf(g) * uu);
          }
        }
      }
  };
  gemm_tile<1024>(smem, nvalid, rowA, rowB, epi);
}

__device__ __forceinline__ void moe_down_tile(const Params& p, char* smem, int l, int e, int nt, int b, int mt, bool isctx, int ks) {
  char* ws = p.ws;
  LAUNDER(ws); LAUNDER(l);
  const u16* W = (const u16*)(ws + OFF_WDT) + (size_t)(l * 16 + e) * 1024 * 2048;
  const int* idxL = (const int*)(ws + OFF_SELI) + (b * 16 + e) * 1024 + mt * 256;
  const float* gtL = (const float*)(ws + OFF_SELG) + (b * 16 + e) * 1024 + mt * 256;
  const int* idxC = (const int*)(ws + OFF_SELIC);
  const float* gtC = (const float*)(ws + OFF_SELGC);
  const u16* ACTL = (const u16*)(ws + OFF_ACT) + ((size_t)(b * 16 + e) * 1024 + mt * 256) * 2048;
  const u16* ACTC = (const u16*)(ws + OFF_ACTC);
  const int nvalid = isctx ? 64 : 256;
  float* OUT = l == 0 ? (float*)(ws + OFF_XNEW) : p.out;
  const float* MODS = (const float*)(ws + OFF_MODS) + (l * 3) * 6144 + 5120;
  const int koff = ks < 0 ? 0 : ks * 512;
  auto rowA = [&](int r) {
    if (isctx) { int s_ = r < 64 ? r : 0; return ACTC + ((size_t)(((s_ >> 5) * 16 + e) * 32 + (s_ & 31))) * 2048 + koff; }
    return ACTL + (size_t)r * 2048;
  };
  auto rowB = [&](int r) { return W + (size_t)(nt * 128 + r) * 2048 + koff; };
  int* sRow = (int*)(smem + 61440);
  float* sGate = (float*)(smem + 61440 + 1024);
  __syncthreads();
  {
    const int slot = threadIdx.x;
    int row = 0; float gs = 0.f;
    if (slot < nvalid) {
      if (isctx) { int bb = slot >> 5, k = (bb * 16 + e) * 32 + (slot & 31); row = MLAT + bb * 256 + idxC[k]; gs = gtC[k]; }
      else { row = b * 8192 + idxL[slot]; gs = gtL[slot]; }
    }
    sRow[slot] = row; sGate[slot] = gs;
  }
  auto epi = [&](f32x4 (&acc)[8][4], int wr, int wc, int fr, int fq) {
    float g2v[4];
#pragma unroll
    for (int n = 0; n < 4; ++n) g2v[n] = (MODS + (isctx ? 2 : b) * 6144)[nt * 128 + wc * 64 + n * 16 + fr] * (1.0f / NREP(7));
#pragma unroll
    for (int m = 0; m < 8; ++m)
#pragma unroll
      for (int j = 0; j < 4; ++j) {
        int slot = wr * 128 + m * 16 + fq * 4 + j;
        if (slot < nvalid) {
          int row = sRow[slot];
          float gs = sGate[slot];
          float* orow = OUT + (size_t)row * 1024 + nt * 128 + wc * 64 + fr;
#pragma unroll
          for (int n = 0; n < 4; ++n) unsafeAtomicAdd(orow + n * 16, g2v[n] * gs * acc[m][n][j]);
        }
      }
  };
  if (ks < 0) gemm_tile<2048>(smem, nvalid, rowA, rowB, epi);
  else gemm_tile<512>(smem, nvalid, rowA, rowB, epi);
}

__global__ void __launch_bounds__(256, 2) fwd_megakernel(Params p) {
  cg::grid_group grid = cg::this_grid();
  __shared__ __attribute__((aligned(16))) char smem[65536 - 64];
  __shared__ int s_job;
  __shared__ uint4 xb_words;
  const int tid = vtid();
  const int nb = gridDim.x, bid = blockIdx.x;
  char* ws = p.ws;
  LAUNDER(ws);
  if (p.out == nullptr) grid.sync();
  if (threadIdx.x == 0) xb_words = make_uint4(0u, 0u, 0u, 0u);
  __syncthreads();
  const XcdBarrier xb = xcd_barrier_post((unsigned*)(ws + OFF_BAR), (volatile LAS unsigned*)&xb_words);

  for (int job = NJ_TR + bid; job < NJ_P0; job += nb) p0_job(p, smem, job);
  GSYNC();
  for (int part = 0; part < 2; ++part) {
    if ((part ^ (bid & 1)) == 0) {
      p0_transposes(p, smem, bid, nb, 0, J_DEFER);
    } else {
      for (int job = bid; job < 264 + 1024 + 16; job += nb) {
        if (job < 264) norm_job(p, 0, job, true);
        else {
          int q = job - 264;
          int tl = q >> 9, tLsel = 0, ttch = (q >> 2) & 127;
          if (q >= 1024) { tl = 0; tLsel = 1; ttch = (q - 1024) >> 2; }
          taps_job(p, smem, tl, tLsel, ttch, q & 3);
        }
      }
    }
    __syncthreads();
  }
  GSYNC();

  for (int l = 0; l < 2; ++l) {
    for (int rep = 0; rep < NREP(1); ++rep) {
      for (int t = bid; t < 66 * 20; t += nb) inproj_tile(p, smem, l, t / 20, t % 20);
      GSYNC();
    }
    for (int rep = 0; rep < NREP(2); ++rep) {
      int* cntG = (int*)(ws + OFF_CNT) + l + 2 * rep;
      int* cntH = (int*)(ws + OFF_CNT) + 8 + l + 2 * rep;
      int* claim = (int*)(ws + OFF_CLAIM) + (l + 2 * rep) * 2048;
      const int nH = 256, nA = 1024, nAC = l == 0 ? 32 : 0, nHC = l == 0 ? 32 : 0, nP = l == 0 ? 528 : 512;
      const int totalG = nA + nAC + nHC + nP;
      int stage = 1;
      if (tid == 0) {
        unsigned key = xcc_id() * 256 + cu_key();
        stage = (atomicAdd(&claim[key], 1) == 0) ? 0 : 1;
      }
      for (;;) {
        __syncthreads();
        if (tid == 0) {
          int job = -1;
          for (;;) {
            if (stage == 0 || stage == 2) {
              int j = atomicAdd(cntH, 1);
              if (j < nH) { job = j; break; }
              if (stage == 0) { stage = 1; continue; }
              stage = 3;
            } else if (stage == 1) {
              int j = atomicAdd(cntG, 1);
              if (j < totalG) { job = nH + j; break; }
              stage = 2;
            } else {
              if (l != 0 || rep != 0) break;
              int j = atomicAdd((int*)(ws + OFF_CNT) + 16, 1);
              if (j < TR_DEFER / TR_CHUNK) job = -2 - j;
              break;
            }
          }
          s_job = job;
        }
        __syncthreads();
        int job = s_job;
        if (job == -1) break;
        if (job < -1) {
          const int c0_ = J_DEFER + (-2 - job) * TR_CHUNK;
          p0_transposes(p, smem, 0, 1, c0_, c0_ + TR_CHUNK);
          continue;
        }
        if (job < nH) hyena_lat_job(p, smem, l, job);
        else if ((job -= nH) < nA + nAC) {
          int hp = job & 3, rr, b, qrow0;
          if (job < nA) { rr = (job >> 2) & 127; b = job >> 9; qrow0 = b * 8192 + rr * 64; }
          else { int q = job - nA; rr = -1; b = q >> 4; qrow0 = MLAT + b * 256 + ((q >> 2) & 3) * 64; }
          attn_job(p, smem, l, b, qrow0, hp, rr);
        } else if ((job -= nA + nAC) < nHC) {
          hyena_ctx_job(p, smem, job);
        } else {
          job -= nHC;
          int seqrow0 = (job >> 8) * 8192, L = 8192, t0 = (job & 255) * 32;
          if (job >= 512) { int q = job - 512; seqrow0 = MLAT + (q >> 3) * 256; L = 256; t0 = (q & 7) * 32; }
          pool_job(p, smem, l, seqrow0, L, t0);
        }
      }
      GSYNC();
    }
    for (int rep = 0; rep < NREP(3); ++rep) {
      const int ntl = 512 + (l == 0 ? 64 : 0);
      for (int t = bid; t < ntl; t += nb) {
        int mt = t >> 3, nt = t & 7, ks = -1;
        if (t >= 512) { int q = t - 512; ks = q & 3; nt = (q >> 2) & 7; mt = 64 + (q >> 5); }
        outproj_tile(p, smem, l, mt, nt, ks);
      }
      GSYNC();
    }
    for (int rep = 0; rep < NREP(4); ++rep) {
      router_rows(p, smem, l, l == 0 ? MTOT : MLAT);
      GSYNC();
    }
    for (int rep = 0; rep < NREP(5); ++rep) {
      const int nj = l == 0 ? 64 : 32;
      for (int j = bid; j < nj; j += nb) topk_job(p, smem, j & 31, j >= 32);
      GSYNC();
    }
    for (int rep = 0; rep < NREP(6); ++rep) {
      const int nl = 4096, ncx = l == 0 ? 512 : 0;
      for (int t = bid; t < nl + ncx; t += nb) {
        int mt = t & 3, b = (t >> 2) & 1, nt = (t >> 3) & 31, e = t >> 8;
        bool isc = t >= nl;
        if (isc) { int q = t - nl; mt = 0; b = 0; nt = q & 31; e = q >> 5; }
        moe_up_tile(p, smem, l, e, nt, b, mt, isc);
      }
      GSYNC();
    }
    for (int rep = 0; rep < NREP(7); ++rep) {
      const int nl = 1024, ncx = l == 0 ? 512 : 0;
      for (int t = bid; t < nl + ncx; t += nb) {
        int mt = t & 3, b = (t >> 2) & 1, nt = (t >> 3) & 7, e = t >> 6, ks = -1;
        bool isc = t >= nl;
        if (isc) { int q = t - nl; mt = 0; b = 0; ks = q & 3; nt = (q >> 2) & 7; e = q >> 5; }
        moe_down_tile(p, smem, l, e, nt, b, mt, isc, ks);
      }
      GSYNC();
    }
    if (l == 0) {
      for (int job = bid; job < 264; job += nb) norm_job(p, 1, job, false);
      GSYNC();
    }
  }
}

extern "C" void kernel_launch(void* const* d_in, const int* in_sizes, int n_in, void* d_out, int out_size, void* d_ws,
                              size_t ws_size, hipStream_t stream) {
  static int grid_blocks = 0;
  if (!grid_blocks) {
    int dev = 0, cus = 0, per_cu = 0;
    hipGetDevice(&dev);
    hipDeviceGetAttribute(&cus, hipDeviceAttributeMultiprocessorCount, dev);
    hipOccupancyMaxActiveBlocksPerMultiprocessor(&per_cu, fwd_megakernel, 256, 0);
    if (per_cu > 2) per_cu = 2;
    if (per_cu < 1) per_cu = 1;
    grid_blocks = cus * per_cu;
  }
  Params p{};
  const float** pp = (const float**)&p;
  for (int i = 0; i < 28; ++i) pp[i] = (const float*)d_in[i];
  p.out = (float*)d_out;
  p.ws = (char*)d_ws;
  hipMemsetAsync((char*)d_ws + OFF_BAR, 0, 16384, stream);
  void* args[] = {&p};
  hipError_t e = hipLaunchCooperativeKernel((void*)fwd_megakernel, dim3(grid_blocks), dim3(256), args, 0, stream);
  if (e != hipSuccess) fprintf(stderr, "cooperative launch failed: %s (grid %d)\n", hipGetErrorString(e), grid_blocks);
}
```

```cpp
#include <hip/hip_runtime.h>
#include <hip/hip_cooperative_groups.h>
#include <cstdio>
#include <cstdint>
namespace cg = cooperative_groups;

typedef unsigned short u16;
typedef __attribute__((ext_vector_type(8))) short bf16x8;
typedef __attribute__((ext_vector_type(4))) float f32x4;
typedef __attribute__((ext_vector_type(16))) float f32x16;

#define MLAT 16384
#define MTOT 16896
#define EPSF 1e-6f

struct Params {
  const float *x, *c, *ctx, *c_ctx, *w_mod, *b_mod, *norm1_w, *norm2_w, *w_in, *w_out, *q_norm_w, *k_norm_w, *na_rpb,
      *hy_conv_w, *hy_conv_b, *hy_w1, *hy_b1, *hy_w2, *hy_b2, *hy_w3, *hy_freq, *hy_skip, *pool_w, *pool_scale,
      *w_router, *w_gate, *w_up, *w_down;
  float* out;
  char* ws;
};

constexpr size_t OFF_WINT = 0;
constexpr size_t OFF_WOUTT = OFF_WINT + 2ull * 2560 * 1024 * 2;
constexpr size_t OFF_WGUT = OFF_WOUTT + 2ull * 1024 * 1024 * 2;
constexpr size_t OFF_WDT = OFF_WGUT + 2ull * 16 * 4096 * 1024 * 2;
constexpr size_t OFF_MODS = OFF_WDT + 2ull * 16 * 1024 * 2048 * 2;
constexpr size_t OFF_ROPE = OFF_MODS + 2ull * 3 * 6144 * 4;
constexpr size_t OFF_HYH = OFF_ROPE + 2ull * 2048 * 4;
constexpr size_t OFF_FILT = OFF_HYH + 2ull * 8448 * 64 * 4;
constexpr size_t OFF_FILTC = OFF_FILT + 2ull * 2 * 256 * 16384 * 2;
constexpr size_t OFF_FSS = OFF_FILTC + 2ull * 256 * 512 * 2;
constexpr size_t OFF_CNT = OFF_FSS + 2048ull * 4;
constexpr size_t OFF_CLAIM = OFF_CNT + 256;
constexpr size_t OFF_BAR = OFF_CLAIM + 4ull * 2048 * 4;
constexpr size_t OFF_HL = OFF_BAR + 16384;
constexpr size_t OFF_H2 = OFF_HL + (size_t)MTOT * 1024 * 2;
constexpr size_t OFF_UL = OFF_H2 + (size_t)MTOT * 1024 * 2;
constexpr size_t OFF_QROT = OFF_UL + (size_t)MTOT * 2560 * 2;
constexpr size_t OFF_VT = OFF_QROT + (size_t)MLAT * 512 * 2;
constexpr size_t OFF_UT = OFF_VT + 512ull * MTOT * 2;
constexpr size_t OFF_MIX = OFF_UT + 768ull * MTOT * 2;
constexpr size_t OFF_XNEW = OFF_MIX + (size_t)MTOT * 1024 * 2;
constexpr size_t OFF_AFF = OFF_XNEW + (size_t)MTOT * 1024 * 4;
constexpr size_t OFF_AFFC = OFF_AFF + 2ull * 16 * 8192 * 4;
constexpr size_t OFF_SELI = OFF_AFFC + 2ull * 16 * 256 * 4;
constexpr size_t OFF_SELIC = OFF_SELI + 32ull * 1024 * 4;
constexpr size_t OFF_SELG = OFF_SELIC + 32ull * 32 * 4;
constexpr size_t OFF_SELGC = OFF_SELG + 32ull * 1024 * 4;
constexpr size_t OFF_ACT = OFF_SELGC + 32ull * 32 * 4;
constexpr size_t OFF_ACTC = OFF_ACT + 32ull * 1024 * 2048 * 2;
constexpr size_t WS_TOTAL = OFF_ACTC + 32ull * 32 * 2048 * 2;

#ifndef REP_MASK
#define REP_MASK 0
#endif
#define NREP(bit) ((REP_MASK >> (bit)) & 1 ? 2 : 1)
#define GSYNC() do { xcd_barrier(xb); if (REP_MASK & 256) xcd_barrier(xb); } while (0)
#define LAUNDER(v) asm volatile("" : "+s"(v))
__device__ __forceinline__ unsigned xcc_id() { return (unsigned)__builtin_amdgcn_s_getreg(20 | (3 << 11)) & 0xfu; }
__device__ __forceinline__ unsigned cu_key() { return ((unsigned)__builtin_amdgcn_s_getreg(63492) >> 8) & 0xffu; }

#define XB_TMO      128
#define XB_XCNT(j)  (256  + 64 * (j))
#define XB_XSUB(j)  (1280 + 64 * (j))
#define XB_XGEN(j)  (2304 + 64 * (j))
#define XB_TOP      3328
#define XB_TOPGEN   3392
#define XCD_BAR_WORDS 3456
#define XB_SPIN_CAP (1u << 20)
#define LAS __attribute__((address_space(3)))
__device__ __forceinline__ unsigned xb_ld(unsigned* p) { return __hip_atomic_load(p, __ATOMIC_RELAXED, __HIP_MEMORY_SCOPE_AGENT); }
__device__ __forceinline__ unsigned xb_add(unsigned* p, unsigned v) { return __hip_atomic_fetch_add(p, v, __ATOMIC_RELAXED, __HIP_MEMORY_SCOPE_AGENT); }
#define XB_SPIN(cond, bar) do { unsigned _sp = 0; while (cond) { __builtin_amdgcn_s_sleep(1); \
    if ((++_sp & 255u) == 0u) { if (xb_ld(&(bar)[XB_TMO])) break; if (_sp > XB_SPIN_CAP) { atomicAdd(&(bar)[XB_TMO], 1u); break; } } } } while (0)
struct XcdBarrier { unsigned* bar; unsigned x; volatile LAS unsigned* st; };
__device__ __forceinline__ XcdBarrier xcd_barrier_post(unsigned* bar, volatile LAS unsigned* st) {
  XcdBarrier b; b.bar = bar; b.x = xcc_id(); b.st = st;
  if (threadIdx.x == 0) (void)xb_add(&bar[XB_XCNT(b.x)], 1u);
  return b;
}
__device__ __forceinline__ void xcd_barrier_complete(unsigned* bar, unsigned x, unsigned& nloc, unsigned& nx) {
  const unsigned G = gridDim.x * gridDim.y * gridDim.z;
  unsigned sum, cnt, mine, sp = 0u;
  for (;;) {
    sum = 0u; cnt = 0u; mine = 0u;
#pragma unroll
    for (unsigned j = 0; j < 16; ++j) { const unsigned c = xb_ld(&bar[XB_XCNT(j)]); sum += c; cnt += (c > 0u) ? 1u : 0u; mine = (j == x) ? c : mine; }
    if (sum == G) break;
    __builtin_amdgcn_s_sleep(1);
    if ((++sp & 255u) == 0u) { if (xb_ld(&bar[XB_TMO])) break; if (sp > XB_SPIN_CAP) { atomicAdd(&bar[XB_TMO], 1u); break; } }
  }
  nloc = mine > 0u ? mine : 1u; nx = cnt > 0u ? cnt : 1u;
}
__device__ __forceinline__ void xcd_barrier(const XcdBarrier& b) {
  asm volatile("s_waitcnt vmcnt(0)" ::: "memory");
  __syncthreads();
  if (threadIdx.x == 0) {
    unsigned* bar = b.bar;
    __builtin_amdgcn_s_waitcnt(0);
    unsigned nloc = b.st[0], nx = b.st[1];
    if (nloc == 0u) { xcd_barrier_complete(bar, b.x, nloc, nx); b.st[0] = nloc; b.st[1] = nx; }
    const unsigned old = xb_add(&bar[XB_XSUB(b.x)], 1u);
    const unsigned gen = old / nloc;
    if (old + 1u == (gen + 1u) * nloc) {
      __builtin_amdgcn_fence(__ATOMIC_RELEASE, "agent");
      asm volatile("s_waitcnt vmcnt(0)" ::: "memory");
      const unsigned og = xb_add(&bar[XB_TOP], 1u);
      const unsigned tg = og / nx;
      if (og + 1u == (tg + 1u) * nx) xb_add(&bar[XB_TOPGEN], 1u);
      else XB_SPIN(xb_ld(&bar[XB_TOPGEN]) == tg, bar);
      __builtin_amdgcn_fence(__ATOMIC_ACQUIRE, "agent");
      xb_add(&bar[XB_XGEN(b.x)], 1u);
      asm volatile("s_waitcnt vmcnt(0)" ::: "memory");
    } else {
      XB_SPIN(xb_ld(&bar[XB_XGEN(b.x)]) == gen, bar);
      __builtin_amdgcn_fence(__ATOMIC_ACQUIRE, "agent");
      asm volatile("s_waitcnt vmcnt(0)" ::: "memory");
    }
  }
  __syncthreads();
}

__device__ __forceinline__ int vtid() { int t = threadIdx.x; asm volatile("" : "+v"(t)); return t; }
__device__ __forceinline__ u16 f2bf(float f) {
  unsigned u = __float_as_uint(f);
  u += 0x7fffu + ((u >> 16) & 1u);
  return (u16)(u >> 16);
}
__device__ __forceinline__ float bf2f(u16 h) { return __uint_as_float(((unsigned)h) << 16); }
__device__ __forceinline__ unsigned pack2(float a, float b) { return (unsigned)f2bf(a) | ((unsigned)f2bf(b) << 16); }
__device__ __forceinline__ float wave_sum(float v) {
#pragma unroll
  for (int o = 32; o > 0; o >>= 1) v += __shfl_xor(v, o);
  return v;
}
__device__ __forceinline__ float siluf(float x) { return x / (1.f + __expf(-x)); }
__device__ __forceinline__ int gu_row(int mat, int f) {
  int jt = f >> 6, rem = f & 63, wc = rem >> 5, n = (rem >> 4) & 1, i = rem & 15;
  return jt * 128 + wc * 64 + (n + 2 * mat) * 16 + i;
}

template <int K, class FA, class FB, class Epi>
__device__ __forceinline__ void gemm_tile(char* smem, int nvalid_rows, FA rowA, FB rowB, Epi epi) {
  const int tid = vtid(), lane = tid & 63, wid = tid >> 6, wr = wid >> 1, wc = wid & 1, fr = lane & 15, fq = lane >> 4;
  const int seg = tid & 3, r0 = tid >> 2;
  int msub = (nvalid_rows - wr * 128 + 15) >> 4;
  msub = msub < 0 ? 0 : (msub > 8 ? 8 : msub);
  const u16* pa0 = rowA(r0) + seg * 8;
  const u16* pa1 = rowA(r0 + 64) + seg * 8;
  const u16* pa2 = rowA(r0 + 128) + seg * 8;
  const u16* pa3 = rowA(r0 + 192) + seg * 8;
  const u16* pb0 = rowB(r0) + seg * 8;
  const u16* pb1 = rowB(r0 + 64) + seg * 8;
  f32x4 acc[8][4];
#pragma unroll
  for (int m = 0; m < 8; ++m)
#pragma unroll
    for (int n = 0; n < 4; ++n) acc[m][n] = (f32x4){0.f, 0.f, 0.f, 0.f};
  uint4 ra0, ra1, ra2, ra3, rb0, rb1;
  ra0 = *(const uint4*)pa0; ra1 = *(const uint4*)pa1; ra2 = *(const uint4*)pa2; ra3 = *(const uint4*)pa3;
  rb0 = *(const uint4*)pb0; rb1 = *(const uint4*)pb1;
  constexpr int NK = K / 32;
  const int wsw = (seg ^ ((r0 >> 2) & 3)) * 8;
  const int wofsA = r0 * 32 + wsw, wofsB = 256 * 32 + r0 * 32 + wsw;
  __syncthreads();
  {
    u16* B0 = (u16*)smem;
    *(uint4*)&B0[wofsA] = ra0; *(uint4*)&B0[wofsA + 64 * 32] = ra1;
    *(uint4*)&B0[wofsA + 128 * 32] = ra2; *(uint4*)&B0[wofsA + 192 * 32] = ra3;
    *(uint4*)&B0[wofsB] = rb0; *(uint4*)&B0[wofsB + 64 * 32] = rb1;
  }
  ra0 = *(const uint4*)(pa0 + 32); ra1 = *(const uint4*)(pa1 + 32); ra2 = *(const uint4*)(pa2 + 32); ra3 = *(const uint4*)(pa3 + 32);
  rb0 = *(const uint4*)(pb0 + 32); rb1 = *(const uint4*)(pb1 + 32);
  __syncthreads();
  const int rsw = (fq ^ ((fr >> 2) & 3)) * 8;
  const int rdA = (wr * 128 + fr) * 32 + rsw, rdB = 256 * 32 + (wc * 64 + fr) * 32 + rsw;
  for (int kt = 0; kt < NK; ++kt) {
    const u16* Bc = (const u16*)(smem + (kt & 1) * 24576);
    bf16x8 Bt[4];
#pragma unroll
    for (int n = 0; n < 4; ++n) Bt[n] = *(const bf16x8*)&Bc[rdB + n * 16 * 32];
    if (msub > 0) {
      bf16x8 At[4];
#pragma unroll
      for (int m = 0; m < 4; ++m) At[m] = *(const bf16x8*)&Bc[rdA + m * 16 * 32];
      __builtin_amdgcn_s_setprio(1);
#pragma unroll
      for (int m = 0; m < 4; ++m)
#pragma unroll
        for (int n = 0; n < 4; ++n) acc[m][n] = __builtin_amdgcn_mfma_f32_16x16x32_bf16(At[m], Bt[n], acc[m][n], 0, 0, 0);
      __builtin_amdgcn_s_setprio(0);
    }
    if (msub > 4) {
      bf16x8 At[4];
#pragma unroll
      for (int m = 0; m < 4; ++m) At[m] = *(const bf16x8*)&Bc[rdA + (m + 4) * 16 * 32];
      __builtin_amdgcn_s_setprio(1);
#pragma unroll
      for (int m = 0; m < 4; ++m)
#pragma unroll
        for (int n = 0; n < 4; ++n) acc[m + 4][n] = __builtin_amdgcn_mfma_f32_16x16x32_bf16(At[m], Bt[n], acc[m + 4][n], 0, 0, 0);
      __builtin_amdgcn_s_setprio(0);
    }
    if (kt + 1 < NK) {
      u16* Bn = (u16*)(smem + ((kt + 1) & 1) * 24576);
      *(uint4*)&Bn[wofsA] = ra0; *(uint4*)&Bn[wofsA + 64 * 32] = ra1;
      *(uint4*)&Bn[wofsA + 128 * 32] = ra2; *(uint4*)&Bn[wofsA + 192 * 32] = ra3;
      *(uint4*)&Bn[wofsB] = rb0; *(uint4*)&Bn[wofsB + 64 * 32] = rb1;
    }
    if (kt + 2 < NK) {
      const int ko = (kt + 2) * 32;
      ra0 = *(const uint4*)(pa0 + ko); ra1 = *(const uint4*)(pa1 + ko); ra2 = *(const uint4*)(pa2 + ko); ra3 = *(const uint4*)(pa3 + ko);
      rb0 = *(const uint4*)(pb0 + ko); rb1 = *(const uint4*)(pb1 + ko);
    }
    __syncthreads();
  }
  epi(acc, wr, wc, fr, fq);
}

struct TrJob { const float* src; u16* dst; int K, N, kt, nt, mode; };
constexpr int TJ_PER_LAYER = 640 + 256 + 16 * 1536;
constexpr int NJ_TR = 2 * TJ_PER_LAYER;
constexpr int TR_DEFER = 10240, TR_CHUNK = 32, J_DEFER = NJ_TR - TR_DEFER;
constexpr int NJ_MOD = 192;
constexpr int NJ_HID = 2 * 256 + 8;
constexpr int NJ_P0 = NJ_TR + NJ_MOD + NJ_HID + 1;

__device__ __forceinline__ TrJob tr_decode(const Params& p, char* ws, int job) {
  TrJob t;
  int l = job / TJ_PER_LAYER, rj = job % TJ_PER_LAYER;
  if (rj < 640) {
    t.src = p.w_in + (size_t)l * 1024 * 2560; t.K = 1024; t.N = 2560; t.kt = rj / 40; t.nt = rj % 40;
    t.dst = (u16*)(ws + OFF_WINT) + (size_t)l * 2560 * 1024; t.mode = 0;
  } else if (rj < 896) {
    rj -= 640;
    t.src = p.w_out + (size_t)l * 1024 * 1024; t.K = 1024; t.N = 1024; t.kt = rj / 16; t.nt = rj % 16;
    t.dst = (u16*)(ws + OFF_WOUTT) + (size_t)l * 1024 * 1024; t.mode = 0;
  } else {
    rj -= 896;
    int e = rj / 1536, q = rj % 1536;
    size_t eo = (size_t)(l * 16 + e);
    if (q < 512) {
      t.src = p.w_gate + eo * 1024 * 2048; t.K = 1024; t.N = 2048; t.kt = q / 32; t.nt = q % 32;
      t.dst = (u16*)(ws + OFF_WGUT) + eo * 4096 * 1024; t.mode = 1;
    } else if (q < 1024) {
      q -= 512;
      t.src = p.w_up + eo * 1024 * 2048; t.K = 1024; t.N = 2048; t.kt = q / 32; t.nt = q % 32;
      t.dst = (u16*)(ws + OFF_WGUT) + eo * 4096 * 1024; t.mode = 2;
    } else {
      q -= 1024;
      t.src = p.w_down + eo * 2048 * 1024; t.K = 2048; t.N = 1024; t.kt = q / 16; t.nt = q % 16;
      t.dst = (u16*)(ws + OFF_WDT) + eo * 1024 * 2048; t.mode = 0;
    }
  }
  return t;
}
__device__ __forceinline__ void tr_load(const Params& p, char* ws, int job, int tid, float4 (&r)[4]) {
  TrJob t = tr_decode(p, ws, job);
  const int c4 = tid & 15, rr = tid >> 4;
  const float* s0 = t.src + (size_t)(t.kt * 64 + rr) * t.N + t.nt * 64 + c4 * 4;
#pragma unroll
  for (int pp = 0; pp < 4; ++pp) {
    f32x4 v_ = __builtin_nontemporal_load((const f32x4*)(s0 + (size_t)(16 * pp) * t.N));
    r[pp] = make_float4(v_[0], v_[1], v_[2], v_[3]);
  }
}
__device__ __forceinline__ void tr_lds_write(float* tile, int tid, const float4 (&r)[4]) {
  const int c4 = tid & 15, rr = tid >> 4;
#pragma unroll
  for (int pp = 0; pp < 4; ++pp) {
    float* t = &tile[(rr + 16 * pp) * 65 + c4 * 4];
    t[0] = r[pp].x; t[1] = r[pp].y; t[2] = r[pp].z; t[3] = r[pp].w;
  }
}
__device__ __forceinline__ void tr_store(const Params& p, char* ws, int job, int tid, const float* tile) {
  TrJob t = tr_decode(p, ws, job);
  const int kc = tid & 7, nn = tid >> 3;
#pragma unroll
  for (int pp = 0; pp < 2; ++pp) {
    int n = nn + 32 * pp;
    float v[8];
#pragma unroll
    for (int j = 0; j < 8; ++j) v[j] = tile[(kc * 8 + j) * 65 + n];
    uint4 o;
    o.x = pack2(v[0], v[1]); o.y = pack2(v[2], v[3]); o.z = pack2(v[4], v[5]); o.w = pack2(v[6], v[7]);
    int gn = t.nt * 64 + n;
    int drow = t.mode == 0 ? gn : gu_row(t.mode - 1, gn);
    *(uint4*)&t.dst[(size_t)drow * t.K + t.kt * 64 + kc * 8] = o;
  }
}
__device__ __forceinline__ void p0_transposes(const Params& p, char* smem, int bid, int nb, int jlo, int jhi) {
  const int tid = vtid();
  char* ws = p.ws;
  LAUNDER(ws);
  float* tileA = (float*)smem;
  float* tileB = tileA + 64 * 65;
  float4 c0[4], c1[4], n0[4], n1[4];
  int j = jlo + bid * 2;
  if (j < jhi) { tr_load(p, ws, j, tid, c0); tr_load(p, ws, j + 1, tid, c1); }
  for (; j < jhi; j += 2 * nb) {
    const int jn = j + 2 * nb;
    if (jn < jhi) { tr_load(p, ws, jn, tid, n0); tr_load(p, ws, jn + 1, tid, n1); }
    tr_lds_write(tileA, tid, c0);
    tr_lds_write(tileB, tid, c1);
    __syncthreads();
    tr_store(p, ws, j, tid, tileA);
    tr_store(p, ws, j + 1, tid, tileB);
    __syncthreads();
#pragma unroll
    for (int q = 0; q < 4; ++q) { c0[q] = n0[q]; c1[q] = n1[q]; }
  }
}

__device__ __forceinline__ void p0_job(const Params& p, char* smem, int job) {
  const int tid = vtid();
  char* ws = p.ws;
  LAUNDER(ws);
  job -= NJ_TR;
  if (job < NJ_MOD) {
    int l = job / 96, cch = job % 96;
    float* sv = (float*)smem;
    for (int i = tid; i < 3072; i += 256) {
      int v = i >> 10, k = i & 1023;
      float s = v < 2 ? p.c[v * 1024 + k] : p.c_ctx[k];
      sv[i] = siluf(s);
    }
    __syncthreads();
    int cj = tid & 63, ks = tid >> 6, col = cch * 64 + cj;
    const float* W = p.w_mod + (size_t)l * 1024 * 6144;
    float a0 = 0.f, a1 = 0.f, a2 = 0.f;
    for (int k = ks * 256; k < ks * 256 + 256; ++k) {
      float w = W[(size_t)k * 6144 + col];
      a0 += sv[k] * w; a1 += sv[1024 + k] * w; a2 += sv[2048 + k] * w;
    }
    __syncthreads();
    sv[(ks * 3 + 0) * 64 + cj] = a0; sv[(ks * 3 + 1) * 64 + cj] = a1; sv[(ks * 3 + 2) * 64 + cj] = a2;
    __syncthreads();
    if (ks < 3) {
      int v = ks;
      float s = sv[(0 * 3 + v) * 64 + cj] + sv[(1 * 3 + v) * 64 + cj] + sv[(2 * 3 + v) * 64 + cj] + sv[(3 * 3 + v) * 64 + cj];
      ((float*)(ws + OFF_MODS))[(l * 3 + v) * 6144 + col] = s + p.b_mod[l * 6144 + col];
    }
    __syncthreads();
    return;
  }
  job -= NJ_MOD;
  if (job < NJ_HID) {
    int l, Lsel, tch;
    if (job < 512) { l = job >> 8; Lsel = 0; tch = job & 255; } else { l = 0; Lsel = 1; tch = job - 512; }
    const int L = Lsel ? 256 : 8192;
    float* zf = (float*)smem;
    float* h1s = zf + 4 * 36;
    const int tg = tid >> 6, j = tid & 63;
    const float* w1 = p.hy_w1 + l * 33 * 64;
    const float* w2 = p.hy_w2 + l * 64 * 64;
    const float b1 = p.hy_b1[l * 64 + j], b2 = p.hy_b2[l * 64 + j], fr = p.hy_freq[l * 64 + j];
    const float wstep = (float)(2.0 * 3.14159265358979323846 / (double)L);
    for (int step = 0; step < 8; ++step) {
      int t = tch * 32 + step * 4 + tg;
      if (j < 33) {
        float z;
        if (j == 0) z = (float)t / (float)(L - 1);
        else {
          int bnd = (j - 1) & 15;
          float f = 1e-4f + (float)bnd * ((15.0f - 1e-4f) / 15.0f);
          float w = wstep * (float)t;
          z = (j <= 16) ? cosf(f * w) : -sinf(f * w);
        }
        zf[tg * 36 + j] = z;
      }
      __syncthreads();
      float a = b1;
      for (int i = 0; i < 33; ++i) a += zf[tg * 36 + i] * w1[i * 64 + j];
      h1s[tg * 64 + j] = sinf(fr * a);
      __syncthreads();
      float a2 = b2;
      for (int i = 0; i < 64; ++i) a2 += h1s[tg * 64 + i] * w2[i * 64 + j];
      ((float*)(ws + OFF_HYH))[((size_t)l * 8448 + (Lsel ? 8192 : 0) + t) * 64 + j] = sinf(fr * a2);
    }
    __syncthreads();
    return;
  }
  {
    float* rope = (float*)(ws + OFF_ROPE);
    for (int i = tid; i < 2048; i += 256) {
      int pos = i >> 4, f = i & 15;
      float inv = powf(10000.0f, -(float)f / 16.0f);
      float ang = (float)pos * inv;
      rope[i] = cosf(ang);
      rope[2048 + i] = sinf(ang);
    }
    float* fss = (float*)(ws + OFF_FSS);
    for (int i = tid; i < 2048; i += 256) fss[i] = 0.f;
    int* cnt = (int*)(ws + OFF_CNT);
    if (tid < 64) cnt[tid] = 0;
    int* claim = (int*)(ws + OFF_CLAIM);
    for (int i = tid; i < 4 * 2048; i += 256) claim[i] = 0;
  }
}

__device__ __forceinline__ void norm_job(const Params& p, int l, int job, bool from_x) {
  const int tid = vtid(), lane = tid & 63, wid = tid >> 6;
  char* ws = p.ws;
  LAUNDER(ws); LAUNDER(l);
  u16* HL = (u16*)(ws + OFF_HL);
  const float* nw = p.norm1_w + l * 1024;
  const int rowbase0 = job * 64 + wid * 16;
  const float* src0;
  if (from_x) src0 = rowbase0 < MLAT ? p.x + (size_t)rowbase0 * 1024 : p.ctx + (size_t)(rowbase0 - MLAT) * 1024;
  else src0 = (const float*)(ws + OFF_XNEW) + (size_t)rowbase0 * 1024;
  float4 nx0, nx1, nx2, nx3;
  nx0 = *(const float4*)&src0[lane * 4]; nx1 = *(const float4*)&src0[lane * 4 + 256];
  nx2 = *(const float4*)&src0[lane * 4 + 512]; nx3 = *(const float4*)&src0[lane * 4 + 768];
  for (int i = 0; i < 16; ++i) {
    int row = rowbase0 + i;
    int v = row < MLAT ? (row >> 13) : 2;
    const float* mods = (const float*)(ws + OFF_MODS) + (l * 3 + v) * 6144;
    float4 xv[4];
    xv[0] = nx0; xv[1] = nx1; xv[2] = nx2; xv[3] = nx3;
    if (i + 1 < 16) {
      const float* sn = src0 + (size_t)(i + 1) * 1024;
      nx0 = *(const float4*)&sn[lane * 4]; nx1 = *(const float4*)&sn[lane * 4 + 256];
      nx2 = *(const float4*)&sn[lane * 4 + 512]; nx3 = *(const float4*)&sn[lane * 4 + 768];
    }
    float ss = 0.f;
#pragma unroll
    for (int q = 0; q < 4; ++q) {
      ss += xv[q].x * xv[q].x + xv[q].y * xv[q].y + xv[q].z * xv[q].z + xv[q].w * xv[q].w;
    }
    ss = wave_sum(ss);
    float rstd = rsqrtf(ss * (1.f / 1024.f) + EPSF);
    if (from_x) {
      float* dstr = (float*)(ws + OFF_XNEW) + (size_t)row * 1024;
#pragma unroll
      for (int q = 0; q < 4; ++q) *(float4*)&dstr[lane * 4 + 256 * q] = xv[q];
    } else if (row < MLAT) {
      float* dstr = p.out + (size_t)row * 1024;
#pragma unroll
      for (int q = 0; q < 4; ++q) *(float4*)&dstr[lane * 4 + 256 * q] = xv[q];
    }
#pragma unroll
    for (int q = 0; q < 4; ++q) {
      int col = lane * 4 + 256 * q;
      float4 w = *(const float4*)&nw[col];
      float4 sh = *(const float4*)&mods[col];
      float4 sc = *(const float4*)&mods[1024 + col];
      float o0 = xv[q].x * rstd * w.x * (1.f + sc.x) + sh.x;
      float o1 = xv[q].y * rstd * w.y * (1.f + sc.y) + sh.y;
      float o2 = xv[q].z * rstd * w.z * (1.f + sc.z) + sh.z;
      float o3 = xv[q].w * rstd * w.w * (1.f + sc.w) + sh.w;
      uint2 o; o.x = pack2(o0, o1); o.y = pack2(o2, o3);
      *(uint2*)&HL[(size_t)row * 1024 + col] = o;
    }
  }
}

__device__ __forceinline__ void taps_job(const Params& p, char* smem, int l, int Lsel, int tch, int cc) {
  const int tid = vtid();
  char* ws = p.ws;
  LAUNDER(ws); LAUNDER(l);
  const int L = Lsel ? 256 : 8192;
  float* hs = (float*)smem;
  u16* ot = (u16*)(smem + 16384);
  const float* HYH = (const float*)(ws + OFF_HYH) + ((size_t)l * 8448 + (Lsel ? 8192 : 0) + tch * 64) * 64;
  for (int i = tid; i < 4096; i += 256) hs[i] = HYH[i];
  float w3r[64];
  const float* w3 = p.hy_w3 + (size_t)l * 64 * 1024 + cc * 256 + tid;
#pragma unroll
  for (int j = 0; j < 64; ++j) w3r[j] = w3[j * 1024];
  __syncthreads();
  const int c = tid, o = cc >> 1, dir = cc & 1;
  const float da = -4.605170185988091f / 1.5f, db = -4.605170185988091f / 0.3f;
  const float delta = fabsf(da + (db - da) * ((float)c / 255.0f));
  float ssp = 0.f;
  for (int tt = 0; tt < 64; ++tt) {
    int t = tch * 64 + tt;
    float a = 0.f;
#pragma unroll
    for (int j = 0; j < 64; ++j) a += hs[tt * 64 + j] * w3r[j];
    float tl = (float)t / (float)(L - 1);
    float val = a * expf(-tl * delta);
    if (!(dir == 1 && t == 0)) ssp += val * val;
    ot[c * 66 + tt] = f2bf(val);
  }
  atomicAdd((float*)(ws + OFF_FSS) + ((l * 2 + Lsel) * 2 + o) * 256 + c, ssp);
  __syncthreads();
  u16* dst = Lsel ? (u16*)(ws + OFF_FILTC) : (u16*)(ws + OFF_FILT) + (size_t)l * 2 * 256 * 16384;
  {
    int tt = tid & 63, cg4 = tid >> 6;
    int t = tch * 64 + tt;
    int m = dir ? L - t : L + t;
    if (!(dir == 1 && t == 0)) {
      for (int ci = cg4; ci < 256; ci += 4) dst[(size_t)(o * 256 + ci) * (2 * L) + m] = ot[ci * 66 + tt];
    }
  }
  __syncthreads();
}

__device__ __forceinline__ void inproj_tile(const Params& p, char* smem, int l, int mt, int nt) {
  char* ws = p.ws;
  LAUNDER(ws); LAUNDER(l);
  const u16* HL = (const u16*)(ws + OFF_HL);
  const u16* W = (const u16*)(ws + OFF_WINT) + (size_t)l * 2560 * 1024;
  u16* UL = (u16*)(ws + OFF_UL);
  u16* QROT = (u16*)(ws + OFF_QROT);
  u16* VT = (u16*)(ws + OFF_VT);
  u16* UT = (u16*)(ws + OFF_UT);
  const float* rope = (const float*)(ws + OFF_ROPE);
  auto rowA = [&](int r) { return HL + (size_t)(mt * 256 + r) * 1024; };
  auto rowB = [&](int r) { return W + (size_t)(nt * 128 + r) * 1024; };
  auto epi = [&](f32x4 (&acc)[8][4], int wr, int wc, int fr, int fq) {
    const int colbase = nt * 128 + wc * 64;
    const int rowbase = mt * 256 + wr * 128;
    if (nt < 8) {
      const bool isq = nt < 4;
      const float* nw = (isq ? p.q_norm_w : p.k_norm_w) + l * 64;
      float w4[4];
#pragma unroll
      for (int n = 0; n < 4; ++n) w4[n] = nw[n * 16 + fr] * (isq ? 0.125f : 1.f);
#pragma unroll
      for (int m = 0; m < 8; ++m)
#pragma unroll
        for (int j = 0; j < 4; ++j) {
          float ss = 0.f;
#pragma unroll
          for (int n = 0; n < 4; ++n) ss += acc[m][n][j] * acc[m][n][j];
          ss += __shfl_xor(ss, 1); ss += __shfl_xor(ss, 2); ss += __shfl_xor(ss, 4); ss += __shfl_xor(ss, 8);
          float rstd = rsqrtf(ss * (1.f / 64.f) + EPSF);
          int row = rowbase + m * 16 + fq * 4 + j;
          float v[4];
#pragma unroll
          for (int n = 0; n < 4; ++n) v[n] = acc[m][n][j] * rstd * w4[n];
          bool lat = row < MLAT;
          float rv[4] = {v[0], v[1], v[2], v[3]};
          if (lat) {
            int t = row & 8191, pr = t >> 6, pc = t & 63;
            float c0 = rope[pr * 16 + fr], s0 = rope[2048 + pr * 16 + fr];
            float c1 = rope[pc * 16 + fr], s1 = rope[2048 + pc * 16 + fr];
            rv[0] = v[0] * c0 - v[1] * s0; rv[1] = v[1] * c0 + v[0] * s0;
            rv[2] = v[2] * c1 - v[3] * s1; rv[3] = v[3] * c1 + v[2] * s1;
          }
          if (isq) {
#pragma unroll
            for (int n = 0; n < 4; ++n) UL[(size_t)row * 2560 + colbase + n * 16 + fr] = f2bf(v[n]);
            if (lat) {
#pragma unroll
              for (int n = 0; n < 4; ++n) QROT[(size_t)row * 512 + colbase + n * 16 + fr] = f2bf(rv[n]);
            }
          } else {
#pragma unroll
            for (int n = 0; n < 4; ++n) UL[(size_t)row * 2560 + colbase + n * 16 + fr] = f2bf(rv[n]);
          }
        }
    } else if (nt < 18) {
      u16* T = nt < 12 ? VT : UT;
      const int cb = colbase - (nt < 12 ? 1024 : 1536);
#pragma unroll
      for (int m = 0; m < 8; ++m)
#pragma unroll
        for (int n = 0; n < 4; ++n) {
          uint2 o; o.x = pack2(acc[m][n][0], acc[m][n][1]); o.y = pack2(acc[m][n][2], acc[m][n][3]);
          *(uint2*)&T[(size_t)(cb + n * 16 + fr) * MTOT + rowbase + m * 16 + fq * 4] = o;
        }
    } else {
#pragma unroll
      for (int m = 0; m < 8; ++m)
#pragma unroll
        for (int n = 0; n < 4; ++n)
#pragma unroll
          for (int j = 0; j < 4; ++j)
            UL[(size_t)(rowbase + m * 16 + fq * 4 + j) * 2560 + colbase + n * 16 + fr] = f2bf(acc[m][n][j]);
    }
  };
  gemm_tile<1024>(smem, 256, rowA, rowB, epi);
}

__device__ __forceinline__ void hyena_lat_job(const Params& p, char* smem, int l, int c) {
  const int tid = vtid(), lane = tid & 63, w = __builtin_amdgcn_readfirstlane(tid >> 6), r = lane & 31, h = lane >> 5;
  char* ws = p.ws;
  LAUNDER(ws); LAUNDER(l);
  u16* zs = (u16*)smem;
  u16* Es = (u16*)(smem + 40960);
  u16* Fs = (u16*)(smem + 40960 + 18688);
  const u16* UT = (const u16*)(ws + OFF_UT);
  u16* MIX = (u16*)(ws + OFF_MIX);
  const float* cw = p.hy_conv_w + l * 3 * 768;
  const float* cb = p.hy_conv_b + l * 768;
  __syncthreads();
  {
    int gc = 512 + c;
    float w0 = cw[gc], w1 = cw[768 + gc], w2 = cw[1536 + gc], bb = cb[gc];
    const u16* u = UT + (size_t)gc * MTOT;
    if (tid < 4) *(unsigned*)&zs[32 + tid * 2] = 0u;
    for (int i4 = tid; i4 < 4096; i4 += 256) {
      int i = i4 * 4;
      int b = i >> 13, t = i & 8191;
      uint2 mid = *(const uint2*)&u[i];
      float um = t > 0 ? bf2f(u[i - 1]) : 0.f, up = t + 4 < 8192 ? bf2f(u[i + 4]) : 0.f;
      float e0 = __uint_as_float(mid.x << 16), e1 = __uint_as_float(mid.x & 0xffff0000u);
      float e2 = __uint_as_float(mid.y << 16), e3 = __uint_as_float(mid.y & 0xffff0000u);
      float z0 = bb + w0 * um + w1 * e0 + w2 * e1;
      float z1 = bb + w0 * e0 + w1 * e1 + w2 * e2;
      float z2 = bb + w0 * e1 + w1 * e2 + w2 * e3;
      float z3 = bb + w0 * e2 + w1 * e3 + w2 * up;
      uint2 o; o.x = pack2(z0, z1); o.y = pack2(z2, z3);
      *(uint2*)&zs[b * 10240 + (t >> 5) * 40 + (t & 31)] = o;
    }
  }
  const int b = r >> 4, ib = 16 * w + (r & 15);
  const unsigned zs_lds = (unsigned)(uintptr_t)(__attribute__((address_space(3))) char*)(char*)zs;
  const int be = r - 8 * h + 8;
  const unsigned es_lds = (unsigned)(uintptr_t)(__attribute__((address_space(3))) char*)(char*)Es;
  const unsigned eb_al = es_lds + (unsigned)((be & ~7) * 16);
  unsigned exo[4];
#pragma unroll
  for (int k = 0; k < 4; ++k) exo[k] = (unsigned)((((be & 7) ^ (((be >> 3) + 2 * k) & 7))) * 16);
  const int sig_lo = 128 * w - 511, sig_hi = 128 * w + 120;
  for (int o = 0; o < 2; ++o) {
    const u16* filt = (const u16*)(ws + OFF_FILT) + ((size_t)((l * 2 + o) * 256 + c)) * 16384;
    f32x16 acc[4];
#pragma unroll
    for (int m = 0; m < 4; ++m)
#pragma unroll
      for (int q = 0; q < 16; ++q) acc[m][q] = 0.f;
    u16 pfv[5];
#pragma unroll
    for (int q = 0; q < 5; ++q) {
      int idx = 16 * (-512) - 8 + 8192 - 7 + tid + 256 * q;
      idx = idx < 0 ? 0 : (idx > 16383 ? 16383 : idx);
      pfv[q] = filt[idx];
    }
    for (int ch = 0; ch < 16; ++ch) {
      const int sc = -512 + ch * 64;
      const int mbase = 16 * sc - 8;
      __syncthreads();
#pragma unroll
      for (int q = 0; q < 5; ++q) { int e = tid + 256 * q; if (e < 1176) Fs[e] = pfv[q]; }
      __syncthreads();
      if (tid < 146) {
        const uint4 lo = *(const uint4*)&Fs[8 * tid], hi = *(const uint4*)&Fs[8 * tid + 8];
        const unsigned W[8] = {lo.x, lo.y, lo.z, lo.w, hi.x, hi.y, hi.z, hi.w};
#pragma unroll
        for (int i = 0; i < 8; ++i) {
          unsigned dw[4];
#pragma unroll
          for (int d = 0; d < 4; ++d) {
            if ((i & 1) == 0) { const unsigned w_ = W[i / 2 + 3 - d]; dw[d] = (w_ >> 16) | (w_ << 16); }
            else { const int k_ = (i - 1) / 2 + 3 - d; dw[d] = (W[k_ + 1] & 0xffffu) | (W[k_] & 0xffff0000u); }
          }
          *(uint4*)&Es[(8 * tid + (i ^ (tid & 7))) * 8] = make_uint4(dw[0], dw[1], dw[2], dw[3]);
        }
      }
      __syncthreads();
      if (ch + 1 < 16) {
#pragma unroll
        for (int q = 0; q < 5; ++q) {
          int idx = mbase + 1024 + 8192 - 7 + tid + 256 * q;
          idx = idx < 0 ? 0 : (idx > 16383 ? 16383 : idx);
          pfv[q] = filt[idx];
        }
      }
      bf16x8 ring[8];
#pragma unroll
      for (int u = 0; u < 8; ++u) {
        const int k_ = u < 7 ? u : 0;
        ring[u] = *(const bf16x8*)((const char*)Es + ((be & ~7) + 16 * k_) * 16 + exo[k_ & 3]);
      }
      bf16x8 bq0, bq1;
      {
        int S = 8 * ib - sc;
        int za = (S >= 0 && S < 512) ? b * 10240 + (S >> 1) * 40 + (S & 1) * 16 + 8 * h : 32;
        bq0 = *(const bf16x8*)&zs[za];
        bq1 = bq0;
      }
#define DS_READ128(dst, addr) asm volatile("ds_read_b128 %0, %1" : "=v"(dst) : "v"(addr))
#define HY_STEP(U, BCUR, BNEXT)                                                                              \
  {                                                                                                          \
    const int sl = g8 * 8 + (U);                                                                             \
    const int sg = sc + sl;                                                                                  \
    const unsigned ea = eb_al + 256u * (unsigned)(sl + 7) + exo[((U) + 7) & 3];                              \
    const int S_ = 8 * ib - sg - 1;                                                                          \
    const unsigned za_ = zs_lds + 2u * (unsigned)((S_ >= 0 && S_ < 512) ? b * 10240 + (S_ >> 1) * 40 + (S_ & 1) * 16 + 8 * h : 32); \
    DS_READ128(ring[((U) + 7) & 7], ea);                                                                     \
    DS_READ128(BNEXT, za_);                                                                                  \
    asm volatile("s_waitcnt lgkmcnt(2)" : "+v"(BCUR), "+v"(ring[((U) + 6) & 7]));                           \
    if (sg >= sig_lo && sg <= sig_hi) {                                                                      \
      acc[0] = __builtin_amdgcn_mfma_f32_32x32x16_bf16(ring[(U)], BCUR, acc[0], 0, 0, 0);                    \
      acc[1] = __builtin_amdgcn_mfma_f32_32x32x16_bf16(ring[((U) + 2) & 7], BCUR, acc[1], 0, 0, 0);          \
      acc[2] = __builtin_amdgcn_mfma_f32_32x32x16_bf16(ring[((U) + 4) & 7], BCUR, acc[2], 0, 0, 0);          \
      acc[3] = __builtin_amdgcn_mfma_f32_32x32x16_bf16(ring[((U) + 6) & 7], BCUR, acc[3], 0, 0, 0);          \
    }                                                                                                        \
    __builtin_amdgcn_sched_barrier(0);                                                                       \
  }
      for (int g8 = 0; g8 < 8; ++g8) {
        HY_STEP(0, bq0, bq1) HY_STEP(1, bq1, bq0) HY_STEP(2, bq0, bq1) HY_STEP(3, bq1, bq0)
        HY_STEP(4, bq0, bq1) HY_STEP(5, bq1, bq0) HY_STEP(6, bq0, bq1) HY_STEP(7, bq1, bq0)
      }
      asm volatile("s_waitcnt lgkmcnt(0)" ::: "memory");
#undef HY_STEP
#undef DS_READ128
    }
    const float scale = rsqrtf(((const float*)(ws + OFF_FSS))[((l * 2 + 0) * 2 + o) * 256 + c] + EPSF);
    const float skip = p.hy_skip[(l * 2 + o) * 256 + c];
    const int gc = o * 256 + c;
    const float w0 = cw[gc], w1 = cw[768 + gc], w2 = cw[1536 + gc], bb = cb[gc];
    const u16* u = UT + (size_t)gc * MTOT + b * 8192;
    __syncthreads();
    int tb = 128 * ib + 4 * h;
    asm volatile("" : "+v"(tb));
#pragma unroll
    for (int mt = 0; mt < 4; ++mt)
#pragma unroll
      for (int g = 0; g < 4; ++g) {
        int t0 = tb + 32 * mt + 8 * g;
        float uu[6];
        {
          const uint2 mid = *(const uint2*)&u[t0];
          uu[0] = t0 > 0 ? bf2f(u[t0 - 1]) : 0.f;
          uu[1] = __uint_as_float(mid.x << 16); uu[2] = __uint_as_float(mid.x & 0xffff0000u);
          uu[3] = __uint_as_float(mid.y << 16); uu[4] = __uint_as_float(mid.y & 0xffff0000u);
          uu[5] = t0 + 4 < 8192 ? bf2f(u[t0 + 4]) : 0.f;
        }
        const int zi0 = b * 10240 + (t0 >> 5) * 40 + (t0 & 31);
        const uint2 zo = *(const uint2*)&zs[zi0];
        float zold4[4] = {__uint_as_float(zo.x << 16), __uint_as_float(zo.x & 0xffff0000u),
                          __uint_as_float(zo.y << 16), __uint_as_float(zo.y & 0xffff0000u)};
        float zn4[4];
#pragma unroll
        for (int q = 0; q < 4; ++q) {
          float gate = bb + w0 * uu[q] + w1 * uu[q + 1] + w2 * uu[q + 2];
          zn4[q] = gate * (scale * acc[mt][g * 4 + q] + zold4[q] * skip);
        }
        if (o == 0) {
          uint2 zw; zw.x = pack2(zn4[0], zn4[1]); zw.y = pack2(zn4[2], zn4[3]);
          *(uint2*)&zs[zi0] = zw;
        } else {
#pragma unroll
          for (int q = 0; q < 4; ++q) MIX[(size_t)(b * 8192 + t0 + q) * 1024 + 512 + c] = f2bf(zn4[q]);
        }
      }
  }
  __syncthreads();
}

__device__ __forceinline__ void hyena_ctx_job(const Params& p, char* smem, int job) {
  const int tid = vtid();
  char* ws = p.ws;
  LAUNDER(ws);
  float* zf = (float*)smem;
  float* kf = zf + 512;
  const u16* UT = (const u16*)(ws + OFF_UT);
  u16* MIX = (u16*)(ws + OFF_MIX);
  const float* cw = p.hy_conv_w;
  const float* cb = p.hy_conv_b;
  for (int cc = 0; cc < 8; ++cc) {
    const int c = job * 8 + cc;
    __syncthreads();
    for (int i = tid; i < 1024; i += 256) {
      int o = i >> 9, m = i & 511;
      float scale = rsqrtf(((const float*)(ws + OFF_FSS))[((0 * 2 + 1) * 2 + o) * 256 + c] + EPSF);
      float kv = (m == 0) ? 0.f : bf2f(((const u16*)(ws + OFF_FILTC))[(size_t)(o * 256 + c) * 512 + m]);
      kf[i] = kv * scale;
    }
    {
      int gc = 512 + c;
      float w0 = cw[gc], w1 = cw[768 + gc], w2 = cw[1536 + gc], bb = cb[gc];
      for (int i = tid; i < 512; i += 256) {
        int b = i >> 8, t = i & 255;
        const u16* u = UT + (size_t)gc * MTOT + MLAT + b * 256;
        float um = t > 0 ? bf2f(u[t - 1]) : 0.f, u0 = bf2f(u[t]), up = t < 255 ? bf2f(u[t + 1]) : 0.f;
        zf[i] = bb + w0 * um + w1 * u0 + w2 * up;
      }
    }
    __syncthreads();
    for (int o = 0; o < 2; ++o) {
      int gc = o * 256 + c;
      float w0 = cw[gc], w1 = cw[768 + gc], w2 = cw[1536 + gc], bb = cb[gc];
      float skip = p.hy_skip[(0 * 2 + o) * 256 + c];
      float zn[2];
#pragma unroll
      for (int q = 0; q < 2; ++q) {
        int i = tid + 256 * q;
        int b = i >> 8, t = i & 255;
        float y = 0.f;
        for (int s = 0; s < 256; ++s) y += kf[o * 512 + t - s + 256] * zf[b * 256 + s];
        const u16* u = UT + (size_t)gc * MTOT + MLAT + b * 256;
        float um = t > 0 ? bf2f(u[t - 1]) : 0.f, u0 = bf2f(u[t]), up = t < 255 ? bf2f(u[t + 1]) : 0.f;
        float gate = bb + w0 * um + w1 * u0 + w2 * up;
        zn[q] = gate * (y + zf[i] * skip);
      }
      __syncthreads();
#pragma unroll
      for (int q = 0; q < 2; ++q) {
        int i = tid + 256 * q;
        if (o == 0) zf[i] = zn[q];
        else {
          int b = i >> 8, t = i & 255;
          MIX[(size_t)(MLAT + b * 256 + t) * 1024 + 512 + c] = f2bf(zn[q]);
        }
      }
      __syncthreads();
    }
  }
}

__device__ __forceinline__ void attn_job(const Params& p, char* smem, int l, int b, int qrow0, int hp, int r) {
  const int tid = vtid(), lane = tid & 63, w = tid >> 6;
  char* ws = p.ws;
  LAUNDER(ws); LAUNDER(l);
  u16* Ks = (u16*)smem;
  u16* Vs = (u16*)(smem + 18432);
  float* rp = (float*)(smem + 36864);
  const u16* UL = (const u16*)(ws + OFF_UL);
  const u16* QROT = (const u16*)(ws + OFF_QROT);
  const u16* VT = (const u16*)(ws + OFF_VT);
  u16* MIX = (u16*)(ws + OFF_MIX);
  const int hl = w >> 1, qh = w & 1, head = 2 * hp + hl, ql = lane & 31, h5 = lane >> 5, qc = 32 * qh + ql;
  const bool lat = r >= 0;
  int rs = r - 4; rs = rs < 0 ? 0 : (rs > 120 ? 120 : rs);
  __syncthreads();
  if (lat) {
    for (int i = tid; i < 930; i += 256) {
      int h2 = i / 465, k = i % 465;
      rp[h2 * 480 + k] = p.na_rpb[(size_t)((l * 8 + 2 * hp + h2) * 465) + k];
    }
  }
  const int qrow = qrow0 + qc;
  bf16x8 qp[4], qr[4];
#pragma unroll
  for (int ks = 0; ks < 4; ++ks) {
    qp[ks] = *(const bf16x8*)&UL[(size_t)qrow * 2560 + head * 64 + 16 * ks + 8 * h5];
    qr[ks] = lat ? *(const bf16x8*)&QROT[(size_t)qrow * 512 + head * 64 + 16 * ks + 8 * h5] : qp[ks];
  }
  f32x16 ot[2];
#pragma unroll
  for (int d = 0; d < 2; ++d)
#pragma unroll
    for (int q = 0; q < 16; ++q) ot[d][q] = 0.f;
  float mrun = -1e30f, lrun = 0.f;
  int cs = qc - 8; cs = cs < 0 ? 0 : (cs > 48 ? 48 : cs);
#define ATT_LD(i, PK, PV, KR0)                                                                       \
  {                                                                                                 \
    int q_ = tid + 256 * (i);                                                                       \
    int h2_ = q_ >> 9, key_ = (q_ >> 3) & 63, seg_ = q_ & 7;                                        \
    PK = *(const uint4*)&UL[(size_t)((KR0) + key_) * 2560 + 512 + (2 * hp + h2_) * 64 + seg_ * 8]; \
    PV = *(const uint4*)&VT[(size_t)((2 * hp + h2_) * 64 + key_) * MTOT + (KR0) + seg_ * 8];       \
  }
#define ATT_ST(i, PK, PV)                                                \
  {                                                                      \
    int q_ = tid + 256 * (i);                                            \
    int h2_ = q_ >> 9, key_ = (q_ >> 3) & 63, seg_ = q_ & 7;             \
    *(uint4*)&Ks[(h2_ * 64 + key_) * 72 + seg_ * 8] = PK;                \
    *(uint4*)&Vs[(h2_ * 64 + key_) * 72 + seg_ * 8] = PV;                \
  }
  uint4 pk0, pk1, pk2, pk3, pv0, pv1, pv2, pv3;
  {
    const int ci = lat ? 0 : 8;
    const int keyrow0 = ci < 8 ? b * 8192 + (rs + ci) * 64 : MLAT + b * 256 + (ci - 8) * 64;
    ATT_LD(0, pk0, pv0, keyrow0) ATT_LD(1, pk1, pv1, keyrow0) ATT_LD(2, pk2, pv2, keyrow0) ATT_LD(3, pk3, pv3, keyrow0)
  }
  for (int ci = lat ? 0 : 8; ci < 12; ++ci) {
    __syncthreads();
    ATT_ST(0, pk0, pv0) ATT_ST(1, pk1, pv1) ATT_ST(2, pk2, pv2) ATT_ST(3, pk3, pv3)
    __syncthreads();
    if (ci + 1 < 12) {
      const int cn = ci + 1;
      const int keyrow0 = cn < 8 ? b * 8192 + (rs + cn) * 64 : MLAT + b * 256 + (cn - 8) * 64;
      ATT_LD(0, pk0, pv0, keyrow0) ATT_LD(1, pk1, pv1, keyrow0) ATT_LD(2, pk2, pv2, keyrow0) ATT_LD(3, pk3, pv3, keyrow0)
    }
    f32x16 st[2];
#pragma unroll
    for (int mt = 0; mt < 2; ++mt) {
#pragma unroll
      for (int q = 0; q < 16; ++q) st[mt][q] = 0.f;
#pragma unroll
      for (int ks = 0; ks < 4; ++ks) {
        bf16x8 a = *(const bf16x8*)&Ks[(hl * 64 + 32 * mt + ql) * 72 + 16 * ks + 8 * h5];
        st[mt] = __builtin_amdgcn_mfma_f32_32x32x16_bf16(a, ci < 8 ? qr[ks] : qp[ks], st[mt], 0, 0, 0);
      }
    }
    if (ci < 8) {
      const int rb = (rs + ci - r + 7) * 31;
#pragma unroll
      for (int mt = 0; mt < 2; ++mt)
#pragma unroll
        for (int q = 0; q < 16; ++q) {
          int kc = 32 * mt + (q & 3) + 8 * (q >> 2) + 4 * h5;
          int dd = kc - cs;
          bool valid = dd >= 0 && dd < 16;
          float bias = rp[hl * 480 + (valid ? rb + kc - qc + 15 : 0)];
          st[mt][q] = valid ? st[mt][q] + bias : -1e30f;
        }
    }
    float mx = -1e30f;
#pragma unroll
    for (int mt = 0; mt < 2; ++mt)
#pragma unroll
      for (int q = 0; q < 16; ++q) mx = fmaxf(mx, st[mt][q]);
    mx = fmaxf(mx, __shfl_xor(mx, 32));
    const float mnew = fmaxf(mrun, mx);
    const float alpha = __expf(mrun - mnew);
    float ps = 0.f;
#pragma unroll
    for (int mt = 0; mt < 2; ++mt)
#pragma unroll
      for (int q = 0; q < 16; ++q) {
        float pv = __expf(st[mt][q] - mnew);
        st[mt][q] = pv;
        ps += pv;
      }
    lrun = lrun * alpha + ps;
    mrun = mnew;
#pragma unroll
    for (int d = 0; d < 2; ++d)
#pragma unroll
      for (int q = 0; q < 16; ++q) ot[d][q] *= alpha;
    bf16x8 pf[4];
#pragma unroll
    for (int mt = 0; mt < 2; ++mt)
#pragma unroll
      for (int s = 0; s < 2; ++s) {
        uint4 t4;
        t4.x = pack2(st[mt][8 * s + 0], st[mt][8 * s + 1]);
        t4.y = pack2(st[mt][8 * s + 2], st[mt][8 * s + 3]);
        t4.z = pack2(st[mt][8 * s + 4], st[mt][8 * s + 5]);
        t4.w = pack2(st[mt][8 * s + 6], st[mt][8 * s + 7]);
        pf[2 * mt + s] = *(bf16x8*)&t4;
      }
#pragma unroll
    for (int dt = 0; dt < 2; ++dt)
#pragma unroll
      for (int kst = 0; kst < 4; ++kst) {
        const u16* vb = &Vs[(hl * 64 + 32 * dt + ql) * 72 + 16 * kst + 4 * h5];
        uint2 lo = *(const uint2*)vb;
        uint2 hi = *(const uint2*)(vb + 8);
        uint4 t4; t4.x = lo.x; t4.y = lo.y; t4.z = hi.x; t4.w = hi.y;
        ot[dt] = __builtin_amdgcn_mfma_f32_32x32x16_bf16(*(bf16x8*)&t4, pf[kst], ot[dt], 0, 0, 0);
      }
  }
  const float ltot = lrun + __shfl_xor(lrun, 32);
  const float inv = 1.f / ltot;
#pragma unroll
  for (int dt = 0; dt < 2; ++dt)
#pragma unroll
    for (int g = 0; g < 4; ++g) {
      int dim0 = 32 * dt + 8 * g + 4 * h5;
      uint2 o2;
      o2.x = pack2(ot[dt][4 * g + 0] * inv, ot[dt][4 * g + 1] * inv);
      o2.y = pack2(ot[dt][4 * g + 2] * inv, ot[dt][4 * g + 3] * inv);
      *(uint2*)&MIX[(size_t)qrow * 1024 + head * 64 + dim0] = o2;
    }
  __syncthreads();
}

__device__ __forceinline__ void pool_job(const Params& p, char* smem, int l, int seqrow0, int L, int t0) {
  const int tid = vtid();
  char* ws = p.ws;
  LAUNDER(ws); LAUNDER(l);
  u16* us = (u16*)smem;
  float* ds = (float*)(smem + 24576);
  const u16* UL = (const u16*)(ws + OFF_UL);
  u16* MIX = (u16*)(ws + OFF_MIX);
  __syncthreads();
  for (int q = tid; q < 48 * 32; q += 256) {
    int rr = q >> 5, seg = q & 31;
    int t = t0 - 8 + rr;
    uint4 v = make_uint4(0, 0, 0, 0);
    if (t >= 0 && t < L) v = *(const uint4*)&UL[(size_t)(seqrow0 + t) * 2560 + 2304 + seg * 8];
    *(uint4*)&us[rr * 256 + seg * 8] = v;
  }
  __syncthreads();
  {
    const int ch = tid, g = ch >> 6, wdt = 2 << g;
    for (int tt = 0; tt < 32; ++tt) {
      int t = t0 + tt;
      int lo = t - wdt / 2, hi = lo + wdt;
      lo = lo < 0 ? 0 : lo; hi = hi > L ? L : hi;
      float s = 0.f;
      for (int pp = lo; pp < hi; ++pp) s += bf2f(us[(pp - t0 + 8) * 256 + ch]);
      float mean = s / (float)(hi - lo);
      ds[tt * 256 + ch] = mean - bf2f(us[(tt + 8) * 256 + ch]);
    }
  }
  __syncthreads();
  {
    const int g = tid >> 6, j = tid & 63;
    const float* pw = p.pool_w + (size_t)(l * 4 + g) * 4096;
    float acc[32];
#pragma unroll
    for (int tt = 0; tt < 32; ++tt) acc[tt] = 0.f;
    for (int cch = 0; cch < 64; ++cch) {
      float wv = pw[cch * 64 + j];
#pragma unroll
      for (int tt = 0; tt < 32; ++tt) acc[tt] += ds[tt * 256 + g * 64 + cch] * wv;
    }
    float sc = p.pool_scale[l * 256 + tid];
#pragma unroll
    for (int tt = 0; tt < 32; ++tt) MIX[(size_t)(seqrow0 + t0 + tt) * 1024 + 768 + tid] = f2bf(acc[tt] * sc);
  }
  __syncthreads();
}

__device__ __forceinline__ void outproj_tile(const Params& p, char* smem, int l, int mt, int nt, int ks) {
  char* ws = p.ws;
  LAUNDER(ws); LAUNDER(l);
  const u16* MIX = (const u16*)(ws + OFF_MIX);
  const u16* W = (const u16*)(ws + OFF_WOUTT) + (size_t)l * 1024 * 1024;
  float* XN = (float*)(ws + OFF_XNEW);
  const float* MODS = (const float*)(ws + OFF_MODS);
  const int koff = ks < 0 ? 0 : ks * 256;
  auto rowA = [&](int r) { return MIX + (size_t)(mt * 256 + r) * 1024 + koff; };
  auto rowB = [&](int r) { return W + (size_t)(nt * 128 + r) * 1024 + koff; };
  auto epi = [&](f32x4 (&acc)[8][4], int wr, int wc, int fr, int fq) {
    const int row0 = mt * 256;
    const int v = row0 < MLAT ? (row0 >> 13) : 2;
    float* O = l == 0 ? XN : p.out;
    float gv[4];
#pragma unroll
    for (int n = 0; n < 4; ++n) gv[n] = MODS[(l * 3 + v) * 6144 + 2048 + nt * 128 + wc * 64 + n * 16 + fr];
#pragma unroll
    for (int m = 0; m < 8; ++m)
#pragma unroll
      for (int j = 0; j < 4; ++j) {
        int row = row0 + wr * 128 + m * 16 + fq * 4 + j;
        float* orow = O + (size_t)row * 1024 + nt * 128 + wc * 64 + fr;
#pragma unroll
        for (int n = 0; n < 4; ++n) unsafeAtomicAdd(orow + n * 16, gv[n] * acc[m][n][j]);
      }
  };
  if (ks < 0) gemm_tile<1024>(smem, 256, rowA, rowB, epi);
  else gemm_tile<256>(smem, 256, rowA, rowB, epi);
}

__device__ __forceinline__ void router_rows(const Params& p, char* smem, int l, int nrows) {
  const int tid = vtid(), lane = tid & 63, wid = tid >> 6;
  char* ws = p.ws;
  LAUNDER(ws); LAUNDER(l);
  const float* XR = l == 0 ? (const float*)(ws + OFF_XNEW) : p.out;
  u16* H2 = (u16*)(ws + OFF_H2);
  const float* nw = p.norm2_w + l * 1024;
  const float* wr = p.w_router + (size_t)l * 1024 * 16;
  float* Hs = (float*)smem;
  float* red = Hs + 256 * 36;
  const int ngroups = nrows >> 3;
  for (int grp = blockIdx.x; grp < ngroups; grp += gridDim.x) {
    __syncthreads();
#pragma unroll
    for (int rr = 0; rr < 2; ++rr) {
      const int rl = wid * 2 + rr;
      const int row = grp * 8 + rl;
      const float* src = XR + (size_t)row * 1024;
      int v = row < MLAT ? (row >> 13) : 2;
      const float* mods = (const float*)(ws + OFF_MODS) + (l * 3 + v) * 6144;
      float4 xv[4];
      float ss = 0.f;
#pragma unroll
      for (int q = 0; q < 4; ++q) {
        xv[q] = *(const float4*)&src[lane * 4 + 256 * q];
        ss += xv[q].x * xv[q].x + xv[q].y * xv[q].y + xv[q].z * xv[q].z + xv[q].w * xv[q].w;
      }
      ss = wave_sum(ss);
      float rstd = rsqrtf(ss * (1.f / 1024.f) + EPSF);
#pragma unroll
      for (int q = 0; q < 4; ++q) {
        int col = lane * 4 + 256 * q;
        float4 w = *(const float4*)&nw[col];
        float4 sh = *(const float4*)&mods[3072 + col];
        float4 sc = *(const float4*)&mods[4096 + col];
        float h0 = xv[q].x * rstd * w.x * (1.f + sc.x) + sh.x;
        float h1 = xv[q].y * rstd * w.y * (1.f + sc.y) + sh.y;
        float h2 = xv[q].z * rstd * w.z * (1.f + sc.z) + sh.z;
        float h3 = xv[q].w * rstd * w.w * (1.f + sc.w) + sh.w;
        uint2 o; o.x = pack2(h0, h1); o.y = pack2(h2, h3);
        *(uint2*)&H2[(size_t)row * 1024 + col] = o;
        *(float4*)&Hs[(col >> 2) * 36 + rl * 4] = make_float4(h0, h1, h2, h3);
      }
    }
    __syncthreads();
    {
      const int e = tid & 15, ks = tid >> 4;
      float acc[8];
#pragma unroll
      for (int r = 0; r < 8; ++r) acc[r] = 0.f;
      const float* wp = wr + (size_t)(ks * 64) * 16 + e;
      const float* hp = Hs + (ks * 16) * 36;
#pragma unroll 2
      for (int kg = 0; kg < 16; ++kg) {
        const float w0 = wp[(kg * 4 + 0) * 16], w1 = wp[(kg * 4 + 1) * 16], w2 = wp[(kg * 4 + 2) * 16], w3 = wp[(kg * 4 + 3) * 16];
#pragma unroll
        for (int r = 0; r < 8; ++r) {
          const float4 hv = *(const float4*)&hp[kg * 36 + r * 4];
          acc[r] += hv.x * w0 + hv.y * w1 + hv.z * w2 + hv.w * w3;
        }
      }
#pragma unroll
      for (int r = 0; r < 8; ++r) {
        acc[r] += __shfl_xor(acc[r], 16);
        acc[r] += __shfl_xor(acc[r], 32);
      }
      if (lane < 16) {
#pragma unroll
        for (int r = 0; r < 8; ++r) red[(wid * 8 + r) * 16 + lane] = acc[r];
      }
    }
    __syncthreads();
    if (tid < 128) {
      const int r = tid >> 4, e = tid & 15;
      float lg = red[(0 * 8 + r) * 16 + e] + red[(1 * 8 + r) * 16 + e] + red[(2 * 8 + r) * 16 + e] + red[(3 * 8 + r) * 16 + e];
      float mx = lg;
      mx = fmaxf(mx, __shfl_xor(mx, 1)); mx = fmaxf(mx, __shfl_xor(mx, 2));
      mx = fmaxf(mx, __shfl_xor(mx, 4)); mx = fmaxf(mx, __shfl_xor(mx, 8));
      float ex = expf(lg - mx);
      float sm = ex;
      sm += __shfl_xor(sm, 1); sm += __shfl_xor(sm, 2); sm += __shfl_xor(sm, 4); sm += __shfl_xor(sm, 8);
      float aff = ex / sm;
      const int row = grp * 8 + r;
      if (row < MLAT) ((float*)(ws + OFF_AFF))[((size_t)(row >> 13) * 16 + e) * 8192 + (row & 8191)] = aff;
      else { int rc = row - MLAT; ((float*)(ws + OFF_AFFC))[((size_t)(rc >> 8) * 16 + e) * 256 + (rc & 255)] = aff; }
    }
  }
  __syncthreads();
}

template <int NV>
__device__ __forceinline__ void topk_body(char* smem, const unsigned* A, int* oi, float* og, int cap) {
  const int tid = vtid(), lane = tid & 63, wid = tid >> 6;
  int* red = (int*)smem;
  unsigned v[NV];
#pragma unroll
  for (int q = 0; q < NV; ++q) v[q] = A[tid + 256 * q];
  __syncthreads();
  unsigned T = 0;
  for (int bit = 29; bit >= 0; --bit) {
    const unsigned cand = T | (1u << bit);
    int c = 0;
#pragma unroll
    for (int q = 0; q < NV; ++q) c += (v[q] >= cand) ? 1 : 0;
#pragma unroll
    for (int o = 32; o > 0; o >>= 1) c += __shfl_xor(c, o);
    int* rb = red + (bit & 1) * 4;
    if (lane == 0) rb[wid] = c;
    __syncthreads();
    int tot = rb[0] + rb[1] + rb[2] + rb[3];
    if (tot >= cap) T = cand;
  }
  int cg = 0, ce = 0;
#pragma unroll
  for (int q = 0; q < NV; ++q) { cg += (v[q] > T) ? 1 : 0; ce += (v[q] == T) ? 1 : 0; }
  int sg = cg, se = ce;
#pragma unroll
  for (int o = 1; o < 64; o <<= 1) {
    int tg = __shfl_up(sg, o), te = __shfl_up(se, o);
    if (lane >= o) { sg += tg; se += te; }
  }
  __syncthreads();
  int* ws4 = red + 16;
  if (lane == 63) { ws4[wid] = sg; ws4[4 + wid] = se; }
  __syncthreads();
  int baseg = 0, basee = 0, totg = 0;
#pragma unroll
  for (int w = 0; w < 4; ++w) {
    int a = ws4[w], e = ws4[4 + w];
    if (w < wid) { baseg += a; basee += e; }
    totg += a;
  }
  int pg = baseg + sg - cg, pe = basee + se - ce;
  const int krem = cap - totg;
#pragma unroll
  for (int q = 0; q < NV; ++q) {
    int slot = -1;
    if (v[q] > T) slot = pg++;
    else if (v[q] == T) { int tr = pe++; if (tr < krem) slot = totg + tr; }
    if (slot >= 0 && slot < cap) { oi[slot] = tid + 256 * q; og[slot] = __uint_as_float(v[q]); }
  }
  __syncthreads();
}

__device__ __forceinline__ void topk_job(const Params& p, char* smem, int je, bool isctx) {
  char* ws = p.ws;
  LAUNDER(ws);
  if (!isctx)
    topk_body<32>(smem, (const unsigned*)(ws + OFF_AFF) + (size_t)je * 8192, (int*)(ws + OFF_SELI) + je * 1024,
                  (float*)(ws + OFF_SELG) + je * 1024, 1024);
  else
    topk_body<1>(smem, (const unsigned*)(ws + OFF_AFFC) + (size_t)je * 256, (int*)(ws + OFF_SELIC) + je * 32,
                 (float*)(ws + OFF_SELGC) + je * 32, 32);
}

__device__ __forceinline__ void moe_up_tile(const Params& p, char* smem, int l, int e, int nt, int b, int mt, bool isctx) {
  char* ws = p.ws;
  LAUNDER(ws); LAUNDER(l);
  const u16* H2 = (const u16*)(ws + OFF_H2);
  const u16* W = (const u16*)(ws + OFF_WGUT) + (size_t)(l * 16 + e) * 4096 * 1024;
  const int* idxL = (const int*)(ws + OFF_SELI) + (b * 16 + e) * 1024 + mt * 256;
  const int* idxC = (const int*)(ws + OFF_SELIC);
  u16* ACTL = (u16*)(ws + OFF_ACT) + ((size_t)(b * 16 + e) * 1024 + mt * 256) * 2048;
  u16* ACTC = (u16*)(ws + OFF_ACTC);
  const int nvalid = isctx ? 64 : 256;
  auto rowA = [&](int r) {
    int row;
    if (isctx) { int s_ = r < 64 ? r : 0; int bb = s_ >> 5; row = MLAT + bb * 256 + idxC[(bb * 16 + e) * 32 + (s_ & 31)]; }
    else row = b * 8192 + idxL[r];
    return H2 + (size_t)row * 1024;
  };
  auto rowB = [&](int r) { return W + (size_t)(nt * 128 + r) * 1024; };
  auto epi = [&](f32x4 (&acc)[8][4], int wr, int wc, int fr, int fq) {
#pragma unroll
    for (int m = 0; m < 8; ++m)
#pragma unroll
      for (int j = 0; j < 4; ++j) {
        int slot = wr * 128 + m * 16 + fq * 4 + j;
        if (slot < nvalid) {
          u16* dst = isctx ? ACTC + ((size_t)(((slot >> 5) * 16 + e) * 32 + (slot & 31))) * 2048 : ACTL + (size_t)slot * 2048;
#pragma unroll
          for (int n = 0; n < 2; ++n) {
            int f = nt * 64 + wc * 32 + n * 16 + fr;
            float g = acc[m][n][j], uu = acc[m][n + 2][j];
            dst[f] = f2bf(siluf(g) * uu);
          }
        }
      }
  };
  gemm_tile<1024>(smem, nvalid, rowA, rowB, epi);
}

__device__ __forceinline__ void moe_down_tile(const Params& p, char* smem, int l, int e, int nt, int b, int mt, bool isctx, int ks) {
  char* ws = p.ws;
  LAUNDER(ws); LAUNDER(l);
  const u16* W = (const u16*)(ws + OFF_WDT) + (size_t)(l * 16 + e) * 1024 * 2048;
  const int* idxL = (const int*)(ws + OFF_SELI) + (b * 16 + e) * 1024 + mt * 256;
  const float* gtL = (const float*)(ws + OFF_SELG) + (b * 16 + e) * 1024 + mt * 256;
  const int* idxC = (const int*)(ws + OFF_SELIC);
  const float* gtC = (const float*)(ws + OFF_SELGC);
  const u16* ACTL = (const u16*)(ws + OFF_ACT) + ((size_t)(b * 16 + e) * 1024 + mt * 256) * 2048;
  const u16* ACTC = (const u16*)(ws + OFF_ACTC);
  const int nvalid = isctx ? 64 : 256;
  float* OUT = l == 0 ? (float*)(ws + OFF_XNEW) : p.out;
  const float* MODS = (const float*)(ws + OFF_MODS) + (l * 3) * 6144 + 5120;
  const int koff = ks < 0 ? 0 : ks * 512;
  auto rowA = [&](int r) {
    if (isctx) { int s_ = r < 64 ? r : 0; return ACTC + ((size_t)(((s_ >> 5) * 16 + e) * 32 + (s_ & 31))) * 2048 + koff; }
    return ACTL + (size_t)r * 2048;
  };
  auto rowB = [&](int r) { return W + (size_t)(nt * 128 + r) * 2048 + koff; };
  int* sRow = (int*)(smem + 61440);
  float* sGate = (float*)(smem + 61440 + 1024);
  __syncthreads();
  {
    const int slot = threadIdx.x;
    int row = 0; float gs = 0.f;
    if (slot < nvalid) {
      if (isctx) { int bb = slot >> 5, k = (bb * 16 + e) * 32 + (slot & 31); row = MLAT + bb * 256 + idxC[k]; gs = gtC[k]; }
      else { row = b * 8192 + idxL[slot]; gs = gtL[slot]; }
    }
    sRow[slot] = row; sGate[slot] = gs;
  }
  auto epi = [&](f32x4 (&acc)[8][4], int wr, int wc, int fr, int fq) {
    float g2v[4];
#pragma unroll
    for (int n = 0; n < 4; ++n) g2v[n] = (MODS + (isctx ? 2 : b) * 6144)[nt * 128 + wc * 64 + n * 16 + fr] * (1.0f / NREP(7));
#pragma unroll
    for (int m = 0; m < 8; ++m)
#pragma unroll
      for (int j = 0; j < 4; ++j) {
        int slot = wr * 128 + m * 16 + fq * 4 + j;
        if (slot < nvalid) {
          int row = sRow[slot];
          float gs = sGate[slot];
          float* orow = OUT + (size_t)row * 1024 + nt * 128 + wc * 64 + fr;
#pragma unroll
          for (int n = 0; n < 4; ++n) unsafeAtomicAdd(orow + n * 16, g2v[n] * gs * acc[m][n][j]);
        }
      }
  };
  if (ks < 0) gemm_tile<2048>(smem, nvalid, rowA, rowB, epi);
  else gemm_tile<512>(smem, nvalid, rowA, rowB, epi);
}

__global__ void __launch_bounds__(256, 2) fwd_megakernel(Params p) {
  cg::grid_group grid = cg::this_grid();
  __shared__ __attribute__((aligned(16))) char smem[65536 - 64];
  __shared__ int s_job;
  __shared__ uint4 xb_words;
  const int tid = vtid();
  const int nb = gridDim.x, bid = blockIdx.x;
  char* ws = p.ws;
  LAUNDER(ws);
  if (p.out == nullptr) grid.sync();
  if (threadIdx.x == 0) xb_words = make_uint4(0u, 0u, 0u, 0u);
  __syncthreads();
  const XcdBarrier xb = xcd_barrier_post((unsigned*)(ws + OFF_BAR), (volatile LAS unsigned*)&xb_words);

  for (int job = NJ_TR + bid; job < NJ_P0; job += nb) p0_job(p, smem, job);
  GSYNC();
  for (int part = 0; part < 2; ++part) {
    if ((part ^ (bid & 1)) == 0) {
      p0_transposes(p, smem, bid, nb, 0, J_DEFER);
    } else {
      for (int job = bid; job < 264 + 1024 + 16; job += nb) {
        if (job < 264) norm_job(p, 0, job, true);
        else {
          int q = job - 264;
          int tl = q >> 9, tLsel = 0, ttch = (q >> 2) & 127;
          if (q >= 1024) { tl = 0; tLsel = 1; ttch = (q - 1024) >> 2; }
          taps_job(p, smem, tl, tLsel, ttch, q & 3);
        }
      }
    }
    __syncthreads();
  }
  GSYNC();

  for (int l = 0; l < 2; ++l) {
    for (int rep = 0; rep < NREP(1); ++rep) {
      for (int t = bid; t < 66 * 20; t += nb) inproj_tile(p, smem, l, t / 20, t % 20);
      GSYNC();
    }
    for (int rep = 0; rep < NREP(2); ++rep) {
      int* cntG = (int*)(ws + OFF_CNT) + l + 2 * rep;
      int* cntH = (int*)(ws + OFF_CNT) + 8 + l + 2 * rep;
      int* claim = (int*)(ws + OFF_CLAIM) + (l + 2 * rep) * 2048;
      const int nH = 256, nA = 1024, nAC = l == 0 ? 32 : 0, nHC = l == 0 ? 32 : 0, nP = l == 0 ? 528 : 512;
      const int totalG = nA + nAC + nHC + nP;
      int stage = 1;
      if (tid == 0) {
        unsigned key = xcc_id() * 256 + cu_key();
        stage = (atomicAdd(&claim[key], 1) == 0) ? 0 : 1;
      }
      for (;;) {
        __syncthreads();
        if (tid == 0) {
          int job = -1;
          for (;;) {
            if (stage == 0 || stage == 2) {
              int j = atomicAdd(cntH, 1);
              if (j < nH) { job = j; break; }
              if (stage == 0) { stage = 1; continue; }
              stage = 3;
            } else if (stage == 1) {
              int j = atomicAdd(cntG, 1);
              if (j < totalG) { job = nH + j; break; }
              stage = 2;
            } else {
              if (l != 0 || rep != 0) break;
              int j = atomicAdd((int*)(ws + OFF_CNT) + 16, 1);
              if (j < TR_DEFER / TR_CHUNK) job = -2 - j;
              break;
            }
          }
          s_job = job;
        }
        __syncthreads();
        int job = s_job;
        if (job == -1) break;
        if (job < -1) {
          const int c0_ = J_DEFER + (-2 - job) * TR_CHUNK;
          p0_transposes(p, smem, 0, 1, c0_, c0_ + TR_CHUNK);
          continue;
        }
        if (job < nH) hyena_lat_job(p, smem, l, job);
        else if ((job -= nH) < nA + nAC) {
          int hp = job & 3, rr, b, qrow0;
          if (job < nA) { rr = (job >> 2) & 127; b = job >> 9; qrow0 = b * 8192 + rr * 64; }
          else { int q = job - nA; rr = -1; b = q >> 4; qrow0 = MLAT + b * 256 + ((q >> 2) & 3) * 64; }
          attn_job(p, smem, l, b, qrow0, hp, rr);
        } else if ((job -= nA + nAC) < nHC) {
          hyena_ctx_job(p, smem, job);
        } else {
          job -= nHC;
          int seqrow0 = (job >> 8) * 8192, L = 8192, t0 = (job & 255) * 32;
          if (job >= 512) { int q = job - 512; seqrow0 = MLAT + (q >> 3) * 256; L = 256; t0 = (q & 7) * 32; }
          pool_job(p, smem, l, seqrow0, L, t0);
        }
      }
      GSYNC();
    }
    for (int rep = 0; rep < NREP(3); ++rep) {
      const int ntl = 512 + (l == 0 ? 64 : 0);
      for (int t = bid; t < ntl; t += nb) {
        int mt = t >> 3, nt = t & 7, ks = -1;
        if (t >= 512) { int q = t - 512; ks = q & 3; nt = (q >> 2) & 7; mt = 64 + (q >> 5); }
        outproj_tile(p, smem, l, mt, nt, ks);
      }
      GSYNC();
    }
    for (int rep = 0; rep < NREP(4); ++rep) {
      router_rows(p, smem, l, l == 0 ? MTOT : MLAT);
      GSYNC();
    }
    for (int rep = 0; rep < NREP(5); ++rep) {
      const int nj = l == 0 ? 64 : 32;
      for (int j = bid; j < nj; j += nb) topk_job(p, smem, j & 31, j >= 32);
      GSYNC();
    }
    for (int rep = 0; rep < NREP(6); ++rep) {
      const int nl = 4096, ncx = l == 0 ? 512 : 0;
      for (int t = bid; t < nl + ncx; t += nb) {
        int mt = t & 3, b = (t >> 2) & 1, nt = (t >> 3) & 31, e = t >> 8;
        bool isc = t >= nl;
        if (isc) { int q = t - nl; mt = 0; b = 0; nt = q & 31; e = q >> 5; }
        moe_up_tile(p, smem, l, e, nt, b, mt, isc);
      }
      GSYNC();
    }
    for (int rep = 0; rep < NREP(7); ++rep) {
      const int nl = 1024, ncx = l == 0 ? 512 : 0;
      for (int t = bid; t < nl + ncx; t += nb) {
        int mt = t & 3, b = (t >> 2) & 1, nt = (t >> 3) & 7, e = t >> 6, ks = -1;
        bool isc = t >= nl;
        if (isc) { int q = t - nl; mt = 0; b = 0; ks = q & 3; nt = (q >> 2) & 7; e = q >> 5; }
        moe_down_tile(p, smem, l, e, nt, b, mt, isc, ks);
      }
      GSYNC();
    }
    if (l == 0) {
      for (int job = bid; job < 264; job += nb) norm_job(p, 1, job, false);
      GSYNC();
    }
  }
}

extern "C" void kernel_launch(void* const* d_in, const int* in_sizes, int n_in, void* d_out, int out_size, void* d_ws,
                              size_t ws_size, hipStream_t stream) {
  static int grid_blocks = 0;
  if (!grid_blocks) {
    int dev = 0, cus = 0, per_cu = 0;
    hipGetDevice(&dev);
    hipDeviceGetAttribute(&cus, hipDeviceAttributeMultiprocessorCount, dev);
    hipOccupancyMaxActiveBlocksPerMultiprocessor(&per_cu, fwd_megakernel, 256, 0);
    if (per_cu > 2) per_cu = 2;
    if (per_cu < 1) per_cu = 1;
    grid_blocks = cus * per_cu;
  }
  Params p{};
  const float** pp = (const float**)&p;
  for (int i = 0; i < 28; ++i) pp[i] = (const float*)d_in[i];
  p.out = (float*)d_out;
  p.ws = (char*)d_ws;
  hipMemsetAsync((char*)d_ws + OFF_BAR, 0, 16384, stream);
  void* args[] = {&p};
  hipError_t e = hipLaunchCooperativeKernel((void*)fwd_megakernel, dim3(grid_blocks), dim3(256), args, 0, stream);
  if (e != hipSuccess) fprintf(stderr, "cooperative launch failed: %s (grid %d)\n", hipGetErrorString(e), grid_blocks);
}
```
